# Optimizing an MI355X kernel written in HIP

```python
import math
import jax, jax.numpy as jnp
from jax import lax
import numpy as np

D_MODEL = 4096
BATCH = 8
SEQ = 2048
DEPTH = 2

BLOCK = 128
EPS = 1e-6
NEG = -1e30
A_HEADS = 16
A_Q_LORA = 1536
A_KV_LORA = 512
A_NOPE = 128
A_ROPE = 64
A_V = 128
A_WIDTH = A_HEADS * A_V
ROPE_THETA = 10000.0
B_HEADS = 32
B_KV_HEADS = 4
B_HD = 64
B_WIDTH = B_HEADS * B_HD
WINDOW = 128
C_HEADS = 16
C_HD = 128
C_WIDTH = C_HEADS * C_HD
REL_BUCKETS = 32
REL_MAX_DIST = 128

IN_SIZES = (A_Q_LORA, A_KV_LORA, A_ROPE, A_WIDTH,
            B_WIDTH, B_KV_HEADS * B_HD, B_KV_HEADS * B_HD, B_WIDTH,
            C_WIDTH, C_WIDTH, C_WIDTH, C_HEADS, C_WIDTH)
IN_DIM = sum(IN_SIZES)
N_BRANCH = 3

kernel_name = "hybrid_mla_swa_fox_gated_block"


def rms_norm(x, g):
    xf = x.astype(jnp.float32)
    y = xf * lax.rsqrt(jnp.mean(xf * xf, axis=-1, keepdims=True) + EPS)
    return (y * g.astype(jnp.float32)).astype(x.dtype)


def split_columns(h):
    parts, start = [], 0
    for n in IN_SIZES:
        parts.append(h[..., start:start + n])
        start += n
    return parts


def apply_rope(x, positions):
    half = x.shape[-1] // 2
    inv_freq = ROPE_THETA ** (-jnp.arange(half, dtype=jnp.float32) / half)
    ang = positions.astype(jnp.float32)[..., None] * inv_freq
    cos = jnp.cos(ang)[:, :, None, :]
    sin = jnp.sin(ang)[:, :, None, :]
    xf = x.astype(jnp.float32)
    x1, x2 = xf[..., :half], xf[..., half:]
    return jnp.concatenate([x1 * cos - x2 * sin, x2 * cos + x1 * sin], axis=-1).astype(x.dtype)


def t5_causal_bucket(dist):
    max_exact = REL_BUCKETS // 2
    d = jnp.maximum(dist, 0)
    large = max_exact + (jnp.log(jnp.maximum(d, 1).astype(jnp.float32) / max_exact)
                         / math.log(REL_MAX_DIST / max_exact)
                         * (REL_BUCKETS - max_exact)).astype(jnp.int32)
    large = jnp.minimum(large, REL_BUCKETS - 1)
    return jnp.where(d < max_exact, d, large)


def causal_block_attention(q, k, v, scale, cum_log_f=None):
    b, s, h, dk = q.shape
    dv = v.shape[-1]
    nblk = s // BLOCK
    q_blocks = q.reshape(b, nblk, BLOCK, h, dk).transpose(1, 0, 2, 3, 4)
    key_pos = jnp.arange(s)

    def one_block(i, q_i, cq_i):
        logits = jnp.einsum('bqhd,bshd->bhqs', q_i, k).astype(jnp.float32) * scale
        if cq_i is not None:
            logits = logits + cq_i[..., :, None] - cum_log_f[:, :, None, :]
        q_pos = i * BLOCK + jnp.arange(BLOCK)
        mask = key_pos[None, :] <= q_pos[:, None]
        logits = jnp.where(mask[None, None], logits, NEG)
        p = jax.nn.softmax(logits, axis=-1)
        return jnp.einsum('bhqs,bshd->bqhd', p.astype(v.dtype), v)

    idx = jnp.arange(nblk)
    if cum_log_f is None:
        out = lax.map(lambda a: one_block(a[0], a[1], None), (idx, q_blocks))
    else:
        cq_blocks = cum_log_f.reshape(b, h, nblk, BLOCK).transpose(2, 0, 1, 3)
        out = lax.map(lambda a: one_block(a[0], a[1], a[2]), (idx, q_blocks, cq_blocks))
    return out.transpose(1, 0, 2, 3, 4).reshape(b, s, h, dv)


def sliding_window_attention(q, k, v, sinks, rel_bias):
    b, s, h, d = q.shape
    kvh = k.shape[2]
    g = h // kvh
    nblk = s // BLOCK
    qb = q.reshape(b, nblk, BLOCK, kvh, g, d)
    kb = k.reshape(b, nblk, BLOCK, kvh, d)
    vb = v.reshape(b, nblk, BLOCK, kvh, d)
    pad = ((0, 0), (1, 0), (0, 0), (0, 0), (0, 0))
    k_band = jnp.concatenate([jnp.pad(kb, pad)[:, :-1], kb], axis=2)
    v_band = jnp.concatenate([jnp.pad(vb, pad)[:, :-1], vb], axis=2)
    logits = jnp.einsum('bnqkgd,bnskd->bnkgqs', qb, k_band).astype(jnp.float32) * (d ** -0.5)
    logits = logits + rel_bias.astype(jnp.float32).reshape(kvh, g, BLOCK, 2 * BLOCK)
    dist = jnp.arange(BLOCK)[:, None] + BLOCK - jnp.arange(2 * BLOCK)[None, :]
    key_abs = jnp.arange(nblk)[:, None] * BLOCK - BLOCK + jnp.arange(2 * BLOCK)[None, :]
    valid = ((dist >= 0) & (dist < WINDOW))[None] & (key_abs >= 0)[:, None, :]
    logits = jnp.where(valid[None, :, None, None], logits, NEG)
    sink = jnp.broadcast_to(sinks.astype(jnp.float32).reshape(kvh, g)[None, None, :, :, None, None],
                            logits.shape[:-1] + (1,))
    p = jax.nn.softmax(jnp.concatenate([logits, sink], axis=-1), axis=-1)[..., :-1]
    out = jnp.einsum('bnkgqs,bnskd->bnqkgd', p.astype(v.dtype), v_band)
    return out.reshape(b, s, h * d)


def hybrid_layer(x, positions, rel_bias, pre_g, w_in, q_a_g, kv_a_g, w_uq, w_uk, w_uv,
                 sinks, b_f, w_proj_a, w_proj_b, w_proj_c, w_merge, w_o, post_g):
    b, s, _ = x.shape
    h = rms_norm(x, pre_g)
    proj = h @ w_in
    (a_cq, a_ckv, a_kr, a_z, b_q, b_k, b_v, b_z,
     c_q, c_k, c_v, c_f, c_z) = split_columns(proj)

    cq = rms_norm(a_cq, q_a_g)
    qa = jnp.einsum('bsr,rhd->bshd', cq, w_uq)
    q_a = jnp.concatenate([qa[..., :A_NOPE], apply_rope(qa[..., A_NOPE:], positions)], axis=-1)
    ckv = rms_norm(a_ckv, kv_a_g)
    k_nope = jnp.einsum('bsr,rhd->bshd', ckv, w_uk)
    v_a = jnp.einsum('bsr,rhd->bshd', ckv, w_uv)
    k_rope = apply_rope(a_kr[:, :, None, :], positions)
    k_a = jnp.concatenate([k_nope, jnp.broadcast_to(k_rope, (b, s, A_HEADS, A_ROPE))], axis=-1)
    o_a = causal_block_attention(q_a, k_a, v_a, (A_NOPE + A_ROPE) ** -0.5).reshape(b, s, A_WIDTH)
    o_a = o_a * jax.nn.silu(a_z)

    o_b = sliding_window_attention(b_q.reshape(b, s, B_HEADS, B_HD),
                                   b_k.reshape(b, s, B_KV_HEADS, B_HD),
                                   b_v.reshape(b, s, B_KV_HEADS, B_HD), sinks, rel_bias)
    o_b = o_b * jax.nn.silu(b_z)

    log_f = jax.nn.log_sigmoid((c_f + b_f).astype(jnp.float32))
    cum = jnp.cumsum(log_f, axis=1).transpose(0, 2, 1)
    o_c = causal_block_attention(c_q.reshape(b, s, C_HEADS, C_HD),
                                 c_k.reshape(b, s, C_HEADS, C_HD),
                                 c_v.reshape(b, s, C_HEADS, C_HD), C_HD ** -0.5, cum)
    o_c = o_c.reshape(b, s, C_WIDTH) * jax.nn.silu(c_z)

    gates = jax.nn.sigmoid(h @ w_merge)
    g_a, g_b, g_c = jnp.split(gates, N_BRANCH, axis=-1)
    y = g_a * (o_a @ w_proj_a) + g_b * (o_b @ w_proj_b) + g_c * (o_c @ w_proj_c)
    y = y @ w_o
    return x + rms_norm(y, post_g)


def setup_inputs(seed: int = 0) -> dict:
    key = jax.random.key(seed)
    ks = jax.random.split(key, 20)
    nrm = jax.random.normal
    f32 = jnp.float32
    x = nrm(ks[0], (BATCH, SEQ, D_MODEL), f32)
    positions = jnp.broadcast_to(jnp.arange(SEQ, dtype=jnp.int32)[None, :], (BATCH, SEQ))
    rel_table = 0.5 * nrm(ks[1], (REL_BUCKETS, B_HEADS), f32)
    pre_norm = 1.0 + 0.05 * nrm(ks[2], (DEPTH, D_MODEL), f32)
    w_in = nrm(ks[3], (DEPTH, D_MODEL, IN_DIM), f32) * D_MODEL ** -0.5
    q_a_norm = 1.0 + 0.05 * nrm(ks[4], (DEPTH, A_Q_LORA), f32)
    kv_a_norm = 1.0 + 0.05 * nrm(ks[5], (DEPTH, A_KV_LORA), f32)
    w_uq = nrm(ks[6], (DEPTH, A_Q_LORA, A_HEADS, A_NOPE + A_ROPE), f32) * A_Q_LORA ** -0.5
    w_uk = nrm(ks[7], (DEPTH, A_KV_LORA, A_HEADS, A_NOPE), f32) * A_KV_LORA ** -0.5
    w_uv = nrm(ks[8], (DEPTH, A_KV_LORA, A_HEADS, A_V), f32) * A_KV_LORA ** -0.5
    sinks = 0.5 * nrm(ks[9], (DEPTH, B_HEADS), f32)
    b_f = 1.0 + 0.1 * nrm(ks[10], (DEPTH, C_HEADS), f32)
    w_proj_a = nrm(ks[11], (DEPTH, A_WIDTH, D_MODEL), f32) * A_WIDTH ** -0.5
    w_proj_b = nrm(ks[12], (DEPTH, B_WIDTH, D_MODEL), f32) * B_WIDTH ** -0.5
    w_proj_c = nrm(ks[13], (DEPTH, C_WIDTH, D_MODEL), f32) * C_WIDTH ** -0.5
    w_merge = nrm(ks[14], (DEPTH, D_MODEL, N_BRANCH * D_MODEL), f32) * D_MODEL ** -0.5
    w_o = nrm(ks[15], (DEPTH, D_MODEL, D_MODEL), f32) * D_MODEL ** -0.5
    post_norm = 1.0 + 0.05 * nrm(ks[16], (DEPTH, D_MODEL), f32)
    return {"x": x, "positions": positions, "rel_table": rel_table, "pre_norm": pre_norm,
            "w_in": w_in, "q_a_norm": q_a_norm, "kv_a_norm": kv_a_norm, "w_uq": w_uq,
            "w_uk": w_uk, "w_uv": w_uv, "sinks": sinks, "b_f": b_f, "w_proj_a": w_proj_a,
            "w_proj_b": w_proj_b, "w_proj_c": w_proj_c, "w_merge": w_merge, "w_o": w_o,
            "post_norm": post_norm}


def reference(x, positions, rel_table, pre_norm, w_in, q_a_norm, kv_a_norm, w_uq, w_uk, w_uv,
              sinks, b_f, w_proj_a, w_proj_b, w_proj_c, w_merge, w_o, post_norm):
    dist = jnp.arange(BLOCK)[:, None] + BLOCK - jnp.arange(2 * BLOCK)[None, :]
    rel_bias = rel_table[t5_causal_bucket(dist)].transpose(2, 0, 1)
    for l in range(DEPTH):
        x = hybrid_layer(x, positions, rel_bias, pre_norm[l], w_in[l], q_a_norm[l], kv_a_norm[l],
                         w_uq[l], w_uk[l], w_uv[l], sinks[l], b_f[l], w_proj_a[l], w_proj_b[l],
                         w_proj_c[l], w_merge[l], w_o[l], post_norm[l])
    return x
```

```cpp
#include <hip/hip_runtime.h>
#include <cstdio>
#include <cstdint>
#include <cmath>
constexpr int NWAVES = 8;
constexpr int M_ROWS = 16384;
constexpr int M = 16384, DM = 4096, SEQ = 2048, NBATCH = 8, NBIG = 29440, NIN = 16976, NMRG = 12288;
constexpr float LOG2E_F = 1.4426950408889634f;
constexpr float QS_A = 0.07216878364870323f * LOG2E_F;
constexpr float QS_B = 0.125f * LOG2E_F;
constexpr float QS_C = 0.08838834764831845f * LOG2E_F;
constexpr size_t MiB = 1u << 20;
constexpr size_t WS_CTL = 0, CTL_ZERO_BYTES = 1 * MiB;
constexpr size_t WS_W = 2 * MiB, W_LAYER = 323 * MiB, W_BIG = 0, W_UQ = 230 * MiB, W_UKV = 239 * MiB, W_PROJ = 243 * MiB, W_O = 291 * MiB;
constexpr size_t WS_H = 648 * MiB, WS_ACQ = 776 * MiB, WS_ACKV = 824 * MiB, WS_QA = 840 * MiB, WS_KA = 936 * MiB, WS_VA = 1000 * MiB, WS_AZ = 1064 * MiB,
                 WS_CQ = 1128 * MiB, WS_CK = 1192 * MiB, WS_CV = 1256 * MiB, WS_CZ = 1320 * MiB, WS_BQ = 1384 * MiB, WS_BZ = 1448 * MiB, WS_BK = 1512 * MiB, WS_BV = 1520 * MiB,
                 WS_KR = 1528 * MiB, WS_LOGF = 1530 * MiB, WS_CB = 1531 * MiB, WS_RS = 1532 * MiB, WS_ROPEC = 1533 * MiB, WS_ROPES = 1535 * MiB, WS_GATES = 1538 * MiB,
                 WS_OCAT = WS_H, WS_YACC = WS_QA, WS_Y = WS_CQ, WS_Z = WS_GATES, WS_END = 1922 * MiB;
constexpr int CW_TMO = 0, CW_BAR = 4096;
constexpr int RING_OFF = 0, RING_BYTES = 131072, LDSCTL_OFF = RING_BYTES, MISC_OFF = LDSCTL_OFF + 320, LDS_BYTES = 147456;
namespace pg8 {
#define PG8_LAS __attribute__((address_space(3)))
typedef unsigned short bf16_t;
typedef short bf16x8 __attribute__((ext_vector_type(8)));
typedef float f32x4 __attribute__((ext_vector_type(4)));
typedef unsigned u32x4 __attribute__((ext_vector_type(4)));
constexpr int BM = 256, BK = 64, HALF = 128, HTB = HALF * BK * 2  , STAGE_BYTES = 8 * HTB, NXCD = 8, WGM = 8;

__host__ __device__ __forceinline__ int lds_byte(int r, int c) { const int st = (r >> 4) * 2 + (c >> 5), rr = r & 15, cc = c & 31, ob = rr * 64 + cc * 2; return st * 1024 + (ob ^ (((ob >> 9) & 1) << 5)); }
__host__ __device__ __forceinline__ void stage_rc(int b, int& R, int& C) { const int st = b / 1024, sb = b % 1024, swz = sb ^ (((sb >> 9) & 1) << 5); R = (st >> 1) * 16 + swz / 64; C = (st & 1) * 32 + (swz % 64) / 2; }
__host__ __device__ __forceinline__ int perm32(int rho) { const int n = rho >> 4, i = rho & 15; return 8 * (i >> 2) + 4 * n + (i & 3); }

struct Unit { int pm, pn; };
struct Gemm { const bf16_t* A; const bf16_t* Bt; int M, N, K; };

struct StaticOrder {
    int nM, nN, nwg, G, c;
    __host__ __device__ void init(int M, int N, int G_, int c_) { nM = M / BM; nN = N / BM; nwg = nM * nN; G = G_; c = c_; }
    __host__ __device__ bool next(int i, Unit& u) const {
        const long L = (long)i * G + c; if (L >= nwg) return false;
        int wgid = (int)L; { const int q = nwg / NXCD, r = nwg % NXCD, xcd = wgid % NXCD, off = wgid / NXCD; wgid = (xcd < r ? xcd * (q + 1) : r * (q + 1) + (xcd - r) * q) + off; }
        const int nig = WGM * nN, gid = wgid / nig, fm = gid * WGM, gsz = (nM - fm) < WGM ? (nM - fm) : WGM;
        u.pm = fm + ((wgid % nig) % gsz); u.pn = (wgid % nig) / gsz; return true;
    }
    __device__ __forceinline__ void a_ready(const Unit&) const {}
    __device__ __forceinline__ void done(const Unit&) const {}
};

__device__ __forceinline__ unsigned cvt_pk_bf16(float lo, float hi) { unsigned r; asm volatile("v_cvt_pk_bf16_f32 %0, %1, %2" : "=v"(r) : "v"(lo), "v"(hi)); return r; }
__device__ __forceinline__ float bf_lo(unsigned w) { return __uint_as_float(w << 16); }
__device__ __forceinline__ float bf_hi(unsigned w) { return __uint_as_float(w & 0xffff0000u); }
__device__ __forceinline__ float sigmoidf_(float v) { return __builtin_amdgcn_rcpf(1.0f + __builtin_amdgcn_exp2f(-1.4426950408889634f * v)); }
__device__ __forceinline__ u32x4 pack8(f32x4 a, f32x4 b) { u32x4 w; w.x = cvt_pk_bf16(a[0], a[1]); w.y = cvt_pk_bf16(a[2], a[3]); w.z = cvt_pk_bf16(b[0], b[1]); w.w = cvt_pk_bf16(b[2], b[3]); return w; }

struct EpiBig {
    static constexpr bool PERM = true, AFTER_DRAIN = false;
    unsigned char* ws;
    const float* bfp;
    int layer;
    __device__ __forceinline__ void operator()(const f32x4 (&acc)[2][2][4][2], const Unit& u, int wr, int wc, int fr, int fq) const {
        constexpr size_t o_acq = WS_ACQ, o_ackv = WS_ACKV, o_az = WS_AZ, o_bq = WS_BQ, o_bk = WS_BK, o_bv = WS_BV, o_bz = WS_BZ, o_cq = WS_CQ, o_ck = WS_CK, o_cv = WS_CV, o_cz = WS_CZ,
                         o_kr = WS_KR, o_logf = WS_LOGF, o_gates = WS_GATES;
        constexpr float qs_b = QS_B, qs_c = QS_C;
        float* rsq = (float*)(ws + WS_RS) + (size_t)layer * 2 * M_ROWS; float* rskv = rsq + M_ROWS;
        const float* ropeC = (const float*)(ws + WS_ROPEC); const float* ropeS = (const float*)(ws + WS_ROPES);
        const int pn = u.pn;
        const int row0 = u.pm * BM + wr * 64 + fr;
        const int lc0 = wc * 32 + 8 * fq;
        if (pn == 66) {
            if (lc0 < 64) {
                const int i0 = (lc0 >> 3) * 4;
#pragma unroll
                for (int ai = 0; ai < 2; ++ai)
#pragma unroll
                    for (int m = 0; m < 4; ++m) { const int row = row0 + ai * HALF + m * 16;
                        const f32x4 c = *(const f32x4*)(ropeC + (size_t)row * 32 + i0), s = *(const f32x4*)(ropeS + (size_t)row * 32 + i0);
                        const f32x4 x1 = acc[ai][0][m][0], x2 = acc[ai][0][m][1];
                        const f32x4 o1 = x1 * c - x2 * s, o2 = x2 * c + x1 * s;
                        *(u32x4*)((bf16_t*)(ws + o_kr) + (size_t)row * 64 + lc0) = pack8(o1, o2); }
            } else if (lc0 < 80) {
                const int h0 = lc0 - 64;
                const f32x4 b0 = *(const f32x4*)(bfp + h0), b1 = *(const f32x4*)(bfp + h0 + 4);
#pragma unroll
                for (int ai = 0; ai < 2; ++ai)
#pragma unroll
                    for (int m = 0; m < 4; ++m) { const int row = row0 + ai * HALF + m * 16;
                        f32x4 v0 = acc[ai][0][m][0] + b0, v1 = acc[ai][0][m][1] + b1;
#pragma unroll
                        for (int e = 0; e < 4; ++e) { v0[e] = fminf(v0[e], 0.f) - __logf(1.0f + __expf(-fabsf(v0[e]))); v1[e] = fminf(v1[e], 0.f) - __logf(1.0f + __expf(-fabsf(v1[e]))); }
                        float* lp = (float*)(ws + o_logf) + (size_t)row * 16 + h0;
                        *(f32x4*)lp = v0; *(f32x4*)(lp + 4) = v1; }
            }
            return;
        }
        size_t off; int ldc, colt; float sc = 1.f; int mode = 0;
        if (pn < 6)       { off = o_acq;  ldc = 1536; colt = pn * 256; mode = 2; }
        else if (pn < 8)  { off = o_ackv; ldc = 512;  colt = (pn - 6) * 256; mode = 3; }
        else if (pn < 16) { off = o_az;   ldc = 2048; colt = (pn - 8) * 256; }
        else if (pn < 24) { off = o_bq;   ldc = 2048; colt = (pn - 16) * 256; sc = qs_b; }
        else if (pn < 25) { off = o_bk;   ldc = 256;  colt = 0; }
        else if (pn < 26) { off = o_bv;   ldc = 256;  colt = 0; }
        else if (pn < 34) { off = o_bz;   ldc = 2048; colt = (pn - 26) * 256; }
        else if (pn < 42) { off = o_cq;   ldc = 2048; colt = (pn - 34) * 256; sc = qs_c; }
        else if (pn < 50) { off = o_ck;   ldc = 2048; colt = (pn - 42) * 256; }
        else if (pn < 58) { off = o_cv;   ldc = 2048; colt = (pn - 50) * 256; }
        else if (pn < 66) { off = o_cz;   ldc = 2048; colt = (pn - 58) * 256; }
        else              { off = o_gates; ldc = 12288; colt = (pn - 67) * 256; mode = 1; }
        bf16_t* base = (bf16_t*)(ws + off);
        const int col0 = colt + lc0;
#pragma unroll
        for (int ai = 0; ai < 2; ++ai)
#pragma unroll
            for (int m = 0; m < 4; ++m) { const int row = row0 + ai * HALF + m * 16; bf16_t* rowp = base + (size_t)row * ldc + col0;
                float ss = 0.f;
#pragma unroll
                for (int bj = 0; bj < 2; ++bj) { f32x4 v0 = acc[ai][bj][m][0], v1 = acc[ai][bj][m][1];
                    if (mode >= 2) ss += (v0[0] * v0[0] + v0[1] * v0[1]) + (v0[2] * v0[2] + v0[3] * v0[3]) + (v1[0] * v1[0] + v1[1] * v1[1]) + (v1[2] * v1[2] + v1[3] * v1[3]);
                    if (mode == 1) {
#pragma unroll
                        for (int e = 0; e < 4; ++e) { v0[e] = sigmoidf_(v0[e]); v1[e] = sigmoidf_(v1[e]); } }
                    else { v0 = v0 * sc; v1 = v1 * sc; }
                    *(u32x4*)(rowp + bj * HALF) = pack8(v0, v1); }
                if (mode >= 2) { ss += __shfl_xor(ss, 16); ss += __shfl_xor(ss, 32);
                    if (fq == 0) unsafeAtomicAdd((mode == 2 ? rsq : rskv) + row, ss); } }
    }
};

struct EpiQA {
    static constexpr bool PERM = true, AFTER_DRAIN = false;
    unsigned char* ws; int layer;
    __device__ __forceinline__ void operator()(const f32x4 (&acc)[2][2][4][2], const Unit& u, int wr, int wc, int fr, int fq) const {
        bf16_t* O = (bf16_t*)(ws + WS_QA); const float* rsq = (const float*)(ws + WS_RS) + (size_t)layer * 2 * M_ROWS;
        const float* ropeC = (const float*)(ws + WS_ROPEC); const float* ropeS = (const float*)(ws + WS_ROPES); constexpr float qs = QS_A;
        const int row0 = u.pm * BM + wr * 64 + fr;
        const int colb = u.pn * BM + wc * 32 + 8 * fq;
#pragma unroll
        for (int ai = 0; ai < 2; ++ai)
#pragma unroll
            for (int m = 0; m < 4; ++m) { const int row = row0 + ai * HALF + m * 16;
                const float rs = __builtin_amdgcn_rsqf(rsq[row] * (1.0f / 1536.0f) + 1e-6f) * qs;
#pragma unroll
                for (int bj = 0; bj < 2; ++bj) { const int col = colb + bj * HALF; const int cm = col % 192;
                    f32x4 v0 = acc[ai][bj][m][0] * rs, v1 = acc[ai][bj][m][1] * rs;
                    if (cm >= 128) { const int i0 = ((cm - 128) >> 3) * 4;
                        const f32x4 c = *(const f32x4*)(ropeC + (size_t)row * 32 + i0), s = *(const f32x4*)(ropeS + (size_t)row * 32 + i0);
                        const f32x4 o1 = v0 * c - v1 * s, o2 = v1 * c + v0 * s; v0 = o1; v1 = o2; }
                    *(u32x4*)(O + (size_t)row * 3072 + col) = pack8(v0, v1); } }
    }
};

struct EpiKV {
    static constexpr bool PERM = true, AFTER_DRAIN = false;
    unsigned char* ws; int layer;
    __device__ __forceinline__ void operator()(const f32x4 (&acc)[2][2][4][2], const Unit& u, int wr, int wc, int fr, int fq) const {
        const float* rskv = (const float*)(ws + WS_RS) + (size_t)layer * 2 * M_ROWS + M_ROWS;
        const int row0 = u.pm * BM + wr * 64 + fr;
        bf16_t* base = (bf16_t*)(ws + (u.pn < 8 ? WS_KA : WS_VA));
        const int col0 = (u.pn & 7) * BM + wc * 32 + 8 * fq;
#pragma unroll
        for (int ai = 0; ai < 2; ++ai)
#pragma unroll
            for (int m = 0; m < 4; ++m) { const int row = row0 + ai * HALF + m * 16;
                const float rs = __builtin_amdgcn_rsqf(rskv[row] * (1.0f / 512.0f) + 1e-6f);
#pragma unroll
                for (int bj = 0; bj < 2; ++bj)
                    *(u32x4*)(base + (size_t)row * 2048 + col0 + bj * HALF) = pack8(acc[ai][bj][m][0] * rs, acc[ai][bj][m][1] * rs); }
    }
};

struct EpiGate {
    static constexpr bool PERM = true, AFTER_DRAIN = false;
    unsigned char* ws;
    __device__ __forceinline__ void operator()(const f32x4 (&acc)[2][2][4][2], const Unit& u, int wr, int wc, int fr, int fq) const {
        const bf16_t* gates = (const bf16_t*)(ws + WS_GATES); float* yacc = (float*)(ws + WS_YACC); bf16_t* Y = (bf16_t*)(ws + WS_Y);
        const int br = u.pm >> 6, pm = u.pm & 63, pn = u.pn & 15;
        const int row0 = pm * BM + wr * 64 + fr, col0 = pn * BM + wc * 32 + 8 * fq;
#pragma unroll
        for (int ai = 0; ai < 2; ++ai)
#pragma unroll
            for (int m = 0; m < 4; ++m) { const int row = row0 + ai * HALF + m * 16;
#pragma unroll
                for (int bj = 0; bj < 2; ++bj) { const int col = col0 + bj * HALF;
                    const u32x4 g = *(const u32x4*)(gates + (size_t)row * 12288 + br * 4096 + col);
                    f32x4 v0 = acc[ai][bj][m][0], v1 = acc[ai][bj][m][1];
                    v0[0] *= bf_lo(g.x); v0[1] *= bf_hi(g.x); v0[2] *= bf_lo(g.y); v0[3] *= bf_hi(g.y);
                    v1[0] *= bf_lo(g.z); v1[1] *= bf_hi(g.z); v1[2] *= bf_lo(g.w); v1[3] *= bf_hi(g.w);
                    float* yp = yacc + (size_t)row * 4096 + col;
                    if (br > 0) { v0 += *(const f32x4*)yp; v1 += *(const f32x4*)(yp + 4); }
                    if (br < 2) { *(f32x4*)yp = v0; *(f32x4*)(yp + 4) = v1; }
                    else *(u32x4*)(Y + (size_t)row * 4096 + col) = pack8(v0, v1); } }
    }
};
struct GateOrder {
    StaticOrder S;
    __device__ __forceinline__ bool next(int i, Unit& u) const { const int t = i / 3, br = i - 3 * t; Unit v; if (!S.next(t, v)) return false; u.pm = br * 64 + v.pm; u.pn = br * 16 + v.pn; return true; }
    __device__ __forceinline__ void a_ready(const Unit&) const {}
    __device__ __forceinline__ void done(const Unit&) const {}
};

struct EpiF32 {
    static constexpr bool PERM = true, AFTER_DRAIN = false;
    float* O; int ldc;
    __device__ __forceinline__ void operator()(const f32x4 (&acc)[2][2][4][2], const Unit& u, int wr, int wc, int fr, int fq) const {
        const int row0 = u.pm * BM + wr * 64 + fr, col0 = u.pn * BM + wc * 32 + 8 * fq;
#pragma unroll
        for (int ai = 0; ai < 2; ++ai)
#pragma unroll
            for (int m = 0; m < 4; ++m) { float* rowp = O + (size_t)(row0 + ai * HALF + m * 16) * ldc + col0;
#pragma unroll
                for (int bj = 0; bj < 2; ++bj) { *(f32x4*)(rowp + bj * HALF) = acc[ai][bj][m][0]; *(f32x4*)(rowp + bj * HALF + 4) = acc[ai][bj][m][1]; } }
    }
};
template <class Epi, class Sched, bool ALIGN_EPI = false, bool SP2 = false>
__device__ __forceinline__ void gemm_phase(PG8_LAS unsigned char* lds, const Gemm g, const Sched& S, const Epi& E) {
    int tid_l = threadIdx.x; asm volatile("" : "+v"(tid_l));
    const int tid = tid_l, wid = __builtin_amdgcn_readfirstlane(tid >> 6), lane = tid & 63, wr = wid >> 2, wc = wid & 3, fr = lane & 15, fq = lane >> 4;
    const int K = g.K, nt = K / BK;
    unsigned voffA[2], voffB[2];
#pragma unroll
    for (int i = 0; i < 2; ++i) { int R, C; stage_rc(tid * 16 + i * 8192, R, C); const int Rb = Epi::PERM ? ((R & ~31) + perm32(R & 31)) : R;
        voffA[i] = (unsigned)(R * K + C) * 2u; voffB[i] = (unsigned)(Rb * K + C) * 2u; }
    const size_t kstep = (size_t)(BK * 2);
    const size_t hstep = (size_t)HALF * K * 2;
    const size_t tstep = 2 * hstep;
    const unsigned ldsw = (unsigned)wid * 1024u;
    const int aoff = lds_byte(wr * 64 + fr, fq * 8), boff = lds_byte(wc * 32 + fr, fq * 8);
#define PG8_SA(b, h) (((b) * 2 + (h)) * HTB)
#define PG8_SB(b, h) ((4 + (b) * 2 + (h)) * HTB)
#define PG8_STAGE(bufoff, gbase, voff) do { _Pragma("unroll") for (int _i = 0; _i < 2; ++_i) \
        __builtin_amdgcn_global_load_lds((const unsigned*)((const char*)(gbase) + (voff)[_i]), (PG8_LAS unsigned*)(lds + (bufoff) + ldsw + _i * 8192), 16, 0, 0); } while (0)
#define PG8_LDA(dst, b, h) do { _Pragma("unroll") for (int m = 0; m < 4; ++m) _Pragma("unroll") for (int k = 0; k < 2; ++k) dst[m][k] = *(const PG8_LAS bf16x8*)(lds + PG8_SA(b, h) + aoff + m * 2048 + k * 1024); } while (0)
#define PG8_LDB(dst, b, h) do { _Pragma("unroll") for (int n = 0; n < 2; ++n) _Pragma("unroll") for (int k = 0; k < 2; ++k) dst[n][k] = *(const PG8_LAS bf16x8*)(lds + PG8_SB(b, h) + boff + n * 2048 + k * 1024); } while (0)
#define PG8_MMA(ai, bj, At, Bt) do { __builtin_amdgcn_s_setprio(1); _Pragma("unroll") for (int m = 0; m < 4; ++m) _Pragma("unroll") for (int n = 0; n < 2; ++n) _Pragma("unroll") for (int k = 0; k < 2; ++k) \
        acc[ai][bj][m][n] = __builtin_amdgcn_mfma_f32_16x16x32_bf16(Bt[n][k], At[m][k], acc[ai][bj][m][n], 0, 0, 0); __builtin_amdgcn_s_setprio(0); } while (0)
#define PG8_WAIT_V(n) asm volatile("s_waitcnt vmcnt(" #n ")" ::: "memory")
#define PG8_WAIT_L(n) asm volatile("s_waitcnt lgkmcnt(" #n ")" ::: "memory")
#define PG8_BAR __builtin_amdgcn_s_barrier()
#define PG8_SCHED __builtin_amdgcn_sched_barrier(0)
    Unit cur, nxt; int ui = 0;
    if (!S.next(0, cur)) return;
    f32x4 acc[2][2][4][2];
#pragma unroll
    for (int a = 0; a < 2; ++a)
#pragma unroll
        for (int b = 0; b < 2; ++b)
#pragma unroll
            for (int m = 0; m < 4; ++m)
#pragma unroll
                for (int n = 0; n < 2; ++n) acc[a][b][m][n] = (f32x4){0.f, 0.f, 0.f, 0.f};
    bf16x8 At[4][2], B0[2][2], B1[2][2];
    const char* cA = (const char*)g.A + (size_t)cur.pm * tstep; const char* cB = (const char*)g.Bt + (size_t)cur.pn * tstep;
    S.a_ready(cur);
    if constexpr (SP2) {
        PG8_STAGE(PG8_SB(0, 0), cB, voffB); PG8_STAGE(PG8_SB(0, 1), cB + hstep, voffB); PG8_STAGE(PG8_SA(0, 0), cA, voffA); PG8_STAGE(PG8_SA(0, 1), cA + hstep, voffA);
        if (wr == 1) PG8_BAR;
        PG8_WAIT_V(2); PG8_BAR;
        PG8_STAGE(PG8_SB(1, 0), cB + kstep, voffB); PG8_STAGE(PG8_SA(1, 0), cA + kstep, voffA); PG8_STAGE(PG8_SB(1, 1), cB + hstep + kstep, voffB);
        PG8_WAIT_V(6); PG8_BAR;
    } else {
        PG8_STAGE(PG8_SB(0, 0), cB, voffB); PG8_STAGE(PG8_SA(0, 0), cA, voffA); PG8_STAGE(PG8_SB(0, 1), cB + hstep, voffB); PG8_STAGE(PG8_SA(0, 1), cA + hstep, voffA);
        if (wr == 1) PG8_BAR;
        PG8_WAIT_V(4); PG8_BAR;
        PG8_STAGE(PG8_SB(1, 0), cB + kstep, voffB); PG8_STAGE(PG8_SA(1, 0), cA + kstep, voffA); PG8_STAGE(PG8_SB(1, 1), cB + hstep + kstep, voffB);
        PG8_WAIT_V(6); PG8_BAR;
    }
    for (;;) {
        const bool has_next = S.next(ui + 1, nxt);
        const char* nA = has_next ? (const char*)g.A + (size_t)nxt.pm * tstep : cA; const char* nB = has_next ? (const char*)g.Bt + (size_t)nxt.pn * tstep : cB;
        for (int t = 0; t < nt; t += 2) {
            const bool last = (t == nt - 2);
            const char* a1 = cA + (size_t)(t + 1) * kstep;
            const char* a2 = last ? nA : cA + (size_t)(t + 2) * kstep; const char* b2 = last ? nB : cB + (size_t)(t + 2) * kstep;
            const char* a3 = a2 + kstep; const char* b3 = b2 + kstep;
            if (last && has_next) S.a_ready(nxt);
            if constexpr (SP2) {
            PG8_LDB(B0, 0, 0); PG8_LDB(B1, 0, 1); PG8_SCHED; PG8_LDA(At, 0, 0); PG8_STAGE(PG8_SA(1, 1), a1 + hstep, voffA);
            PG8_WAIT_V(8); PG8_WAIT_L(0); PG8_BAR; PG8_MMA(0, 0, At, B0); PG8_MMA(0, 1, At, B1); PG8_BAR; PG8_SCHED;
            PG8_LDA(At, 0, 1); PG8_STAGE(PG8_SB(0, 0), b2, voffB); PG8_STAGE(PG8_SB(0, 1), b2 + hstep, voffB); PG8_STAGE(PG8_SA(0, 0), a2, voffA);
            PG8_WAIT_V(8); PG8_WAIT_L(0); PG8_BAR; PG8_MMA(1, 0, At, B0); PG8_MMA(1, 1, At, B1); PG8_BAR; PG8_SCHED;
            PG8_LDB(B0, 1, 0); PG8_LDB(B1, 1, 1); PG8_SCHED; PG8_LDA(At, 1, 0); PG8_STAGE(PG8_SA(0, 1), a2 + hstep, voffA);
            PG8_WAIT_V(8); PG8_WAIT_L(0); PG8_BAR; PG8_MMA(0, 0, At, B0); PG8_MMA(0, 1, At, B1); PG8_BAR; PG8_SCHED;
            PG8_LDA(At, 1, 1); PG8_STAGE(PG8_SB(1, 0), b3, voffB); PG8_STAGE(PG8_SB(1, 1), b3 + hstep, voffB); PG8_STAGE(PG8_SA(1, 0), a3, voffA);
            PG8_WAIT_V(8); PG8_WAIT_L(0); PG8_BAR; PG8_MMA(1, 0, At, B0); PG8_MMA(1, 1, At, B1); PG8_BAR; PG8_SCHED;
            } else {
            PG8_LDB(B0, 0, 0); PG8_SCHED; PG8_LDA(At, 0, 0); PG8_STAGE(PG8_SA(1, 1), a1 + hstep, voffA);
            PG8_WAIT_L(8); PG8_BAR; PG8_WAIT_L(0); PG8_MMA(0, 0, At, B0); PG8_BAR; PG8_SCHED;
            PG8_LDB(B1, 0, 1); PG8_STAGE(PG8_SB(0, 0), b2, voffB);
            PG8_BAR; PG8_WAIT_L(0); PG8_MMA(0, 1, At, B1); PG8_BAR;
            PG8_LDA(At, 0, 1); PG8_STAGE(PG8_SA(0, 0), a2, voffA);
            PG8_BAR; PG8_WAIT_L(0); PG8_MMA(1, 0, At, B0); PG8_BAR; PG8_SCHED;
            PG8_STAGE(PG8_SB(0, 1), b2 + hstep, voffB);
            PG8_WAIT_V(6); PG8_BAR; PG8_MMA(1, 1, At, B1); PG8_BAR;
            PG8_LDB(B0, 1, 0); PG8_SCHED; PG8_LDA(At, 1, 0); PG8_STAGE(PG8_SA(0, 1), a2 + hstep, voffA);
            PG8_WAIT_L(8); PG8_BAR; PG8_WAIT_L(0); PG8_MMA(0, 0, At, B0); PG8_BAR; PG8_SCHED;
            PG8_LDB(B1, 1, 1); PG8_STAGE(PG8_SB(1, 0), b3, voffB);
            PG8_BAR; PG8_WAIT_L(0); PG8_MMA(0, 1, At, B1); PG8_BAR;
            PG8_LDA(At, 1, 1); PG8_STAGE(PG8_SA(1, 0), a3, voffA);
            PG8_BAR; PG8_WAIT_L(0); PG8_MMA(1, 0, At, B0); PG8_BAR; PG8_SCHED;
            PG8_STAGE(PG8_SB(1, 1), b3 + hstep, voffB);
            PG8_WAIT_V(6); PG8_BAR; PG8_MMA(1, 1, At, B1); PG8_BAR;
            }
        }
        if constexpr (ALIGN_EPI) { if (wr == 0) PG8_BAR; }
        if constexpr (!Epi::AFTER_DRAIN) { E(acc, cur, wr, wc, fr, fq); S.done(cur); }
        if (!has_next) break;
#pragma unroll
        for (int a = 0; a < 2; ++a)
#pragma unroll
            for (int b = 0; b < 2; ++b)
#pragma unroll
                for (int m = 0; m < 4; ++m)
#pragma unroll
                    for (int n = 0; n < 2; ++n) acc[a][b][m][n] = (f32x4){0.f, 0.f, 0.f, 0.f};
        cur = nxt; cA = nA; cB = nB; ++ui;
        if constexpr (ALIGN_EPI) { if (wr == 1) PG8_BAR; }
    }
    PG8_WAIT_V(0);
    if constexpr (!ALIGN_EPI) { if (wr == 0) PG8_BAR; }
    PG8_BAR;
    if constexpr (Epi::AFTER_DRAIN) { E.fused(acc, cur, wr, wc, fr, fq, lds, wid, lane); S.done(cur); }
#undef PG8_SA
#undef PG8_SB
#undef PG8_STAGE
#undef PG8_LDA
#undef PG8_LDB
#undef PG8_MMA
#undef PG8_WAIT_V
#undef PG8_WAIT_L
#undef PG8_BAR
#undef PG8_SCHED
}
}
#define GAS __attribute__((address_space(1)))
#define LAS __attribute__((address_space(3)))
typedef unsigned short bf16;
typedef unsigned v4u __attribute__((ext_vector_type(4)));
typedef float f32x4 __attribute__((ext_vector_type(4)));
typedef short bf16x8 __attribute__((ext_vector_type(8)));
typedef GAS unsigned gu32;
typedef GAS unsigned long long gu64;
#define RLX_AGENT __ATOMIC_RELAXED, __HIP_MEMORY_SCOPE_AGENT
#define LDS_WAIT() asm volatile("s_waitcnt lgkmcnt(0)" ::: "memory")
#define VM_WAIT() asm volatile("s_waitcnt vmcnt(0)" ::: "memory")
__device__ __forceinline__ unsigned long long rt() { return __builtin_amdgcn_s_memrealtime(); }
__device__ __forceinline__ unsigned f2bf(float f) { unsigned u = __builtin_bit_cast(unsigned, f); return (u + 0x7fffu + ((u >> 16) & 1u)) >> 16; }
__device__ __forceinline__ unsigned pk2(float lo, float hi) { return f2bf(lo) | (f2bf(hi) << 16); }
#define XB_TMO      128
#define XB_XCNT(j)  (256  + 64 * (j))
#define XB_XSUB(j)  (1280 + 64 * (j))
#define XB_XGEN(j)  (2304 + 64 * (j))
#define XB_TOP      3328
#define XB_TOPGEN   3392
#define XCD_BAR_WORDS 3456
#define XB_SPIN_CAP (1u << 18)

__device__ __forceinline__ unsigned xb_ld(unsigned* p)              { return __hip_atomic_load(p, __ATOMIC_RELAXED, __HIP_MEMORY_SCOPE_AGENT); }
__device__ __forceinline__ unsigned xb_add(unsigned* p, unsigned v) { return __hip_atomic_fetch_add(p, v, __ATOMIC_RELAXED, __HIP_MEMORY_SCOPE_AGENT); }
__device__ __forceinline__ unsigned xb_xcc_id() { return (unsigned)__builtin_amdgcn_s_getreg((3 << 11) | 20) & 0xFu; }
#define XB_SPIN(cond, bar) do { unsigned _sp = 0; while (cond) { __builtin_amdgcn_s_sleep(1); \
    if ((++_sp & 255u) == 0u) { if (xb_ld(&(bar)[XB_TMO])) break; if (_sp > XB_SPIN_CAP) { atomicAdd(&(bar)[XB_TMO], 1u); break; } } } } while (0)

struct XcdBarrier {
    unsigned* bar; unsigned x;
    volatile LAS unsigned* st;
};

__device__ __forceinline__ XcdBarrier xcd_barrier_post(unsigned* bar, volatile LAS unsigned* st) {
    XcdBarrier b; b.bar = bar; b.x = xb_xcc_id(); b.st = st;
    if (threadIdx.x == 0) (void)xb_add(&bar[XB_XCNT(b.x)], 1u);
    return b;
}
__device__ __forceinline__ void xcd_barrier_complete(unsigned* bar, unsigned x, unsigned& nloc, unsigned& nx) {
    const unsigned G = gridDim.x * gridDim.y * gridDim.z;
    unsigned sum, cnt, mine, sp = 0u;
    for (;;) {
        sum = 0u; cnt = 0u; mine = 0u;
#pragma unroll
        for (unsigned j = 0; j < 16; ++j) { const unsigned c = xb_ld(&bar[XB_XCNT(j)]); sum += c; cnt += (c > 0u) ? 1u : 0u; mine = (j == x) ? c : mine; }
        if (sum == G) break;
        __builtin_amdgcn_s_sleep(1);
        if ((++sp & 255u) == 0u) { if (xb_ld(&bar[XB_TMO])) break; if (sp > XB_SPIN_CAP) { atomicAdd(&bar[XB_TMO], 1u); break; } }
    }
    nloc = mine > 0u ? mine : 1u; nx = cnt > 0u ? cnt : 1u;
}

__device__ __forceinline__ void xcd_barrier(const XcdBarrier& b) {
    asm volatile("s_waitcnt vmcnt(0)" ::: "memory");
    __syncthreads();
    if (threadIdx.x == 0) {
        unsigned* bar = b.bar;
        __builtin_amdgcn_s_waitcnt(0);
        unsigned nloc = b.st[0], nx = b.st[1];
        if (nloc == 0u) { xcd_barrier_complete(bar, b.x, nloc, nx); b.st[0] = nloc; b.st[1] = nx; }
        const unsigned old = xb_add(&bar[XB_XSUB(b.x)], 1u);
        const unsigned gen = old / nloc;
        if (old + 1u == (gen + 1u) * nloc) {
            __builtin_amdgcn_fence(__ATOMIC_RELEASE, "agent");
            asm volatile("s_waitcnt vmcnt(0)" ::: "memory");
            const unsigned og = xb_add(&bar[XB_TOP], 1u);
            const unsigned tg = og / nx;
            if (og + 1u == (tg + 1u) * nx) xb_add(&bar[XB_TOPGEN], 1u);
            else XB_SPIN(xb_ld(&bar[XB_TOPGEN]) == tg, bar);
            __builtin_amdgcn_fence(__ATOMIC_ACQUIRE, "agent");
            xb_add(&bar[XB_XGEN(b.x)], 1u);
            asm volatile("s_waitcnt vmcnt(0)" ::: "memory");
        } else {
            XB_SPIN(xb_ld(&bar[XB_XGEN(b.x)]) == gen, bar);
            __builtin_amdgcn_fence(__ATOMIC_ACQUIRE, "agent");
            asm volatile("s_waitcnt vmcnt(0)" ::: "memory");
        }
    }
    __syncthreads();
}
namespace att {
typedef unsigned short bf16_t;
typedef short bf16x8 __attribute__((ext_vector_type(8)));
typedef short s16x4 __attribute__((ext_vector_type(4)));
typedef float f32x16 __attribute__((ext_vector_type(16)));
typedef float f32x4 __attribute__((ext_vector_type(4)));
typedef unsigned u32x4 __attribute__((ext_vector_type(4)));
#define ATT_LAS __attribute__((address_space(3)))
#define ATT_SBAR() __builtin_amdgcn_sched_barrier(0)
constexpr int SEQ = 2048, QB = 256, KVBLK = 64;
constexpr int L_K = 0, L_KSZ = 24576, L_V = 2 * L_KSZ, L_VSZ = 16384, L_WS = L_V + 2 * L_VSZ, L_TAB = L_WS + 8 * 256, L_END = L_TAB + 8192;
constexpr float LOG2E = 1.4426950408889634f;

struct Args {
    const bf16_t* Q; const bf16_t* K; const bf16_t* KR; const bf16_t* V; const bf16_t* Z; bf16_t* O;
    const float* CB;
    const float* relt;
    const float* sinks;
};
template <int KIND> struct Cfg;
template <> struct Cfg<0> { static constexpr int DK = 192, DV = 128, QP = 3072, KP = 2048, VP = 2048, NH = 16, G = 1; };
template <> struct Cfg<1> { static constexpr int DK = 64,  DV = 64,  QP = 2048, KP = 256,  VP = 256,  NH = 32, G = 8; };
template <> struct Cfg<2> { static constexpr int DK = 128, DV = 128, QP = 2048, KP = 2048, VP = 2048, NH = 16, G = 1; };

__device__ __forceinline__ int crow(int r, int hi) { return (r & 3) + 8 * (r >> 2) + 4 * hi; }
__device__ __forceinline__ unsigned cvtpk(float lo, float hi) { unsigned r; asm volatile("v_cvt_pk_bf16_f32 %0, %1, %2" : "=v"(r) : "v"(lo), "v"(hi)); return r; }
template <int DV> __device__ __forceinline__ int v_st(int k, int c) { constexpr int NS = DV / 32; const int kk = (k & ~0xC) | ((k & 4) << 1) | ((k & 8) >> 1); return ((kk >> 3) * NS + (c >> 5)) * 512 + ((kk & 7) * 32 + (c & 31)) * 2; }
__device__ __forceinline__ int v_rd_base(int lane) { return ((lane & 3) << 3) | (((lane >> 2) & 3) << 6) | (((lane >> 4) & 1) << 5) | (((lane >> 5) & 1) << 8); }
template <int DK> __device__ __forceinline__ int k_st(int row, int ch) { return row * (DK * 2) + ((ch ^ (row & 7)) << 4); }

template <int DK, bool BIAS>
__device__ __forceinline__ void qkt(f32x16& p0, f32x16& p1, ATT_LAS const unsigned char* Kt, int r32, int hi, const bf16x8* qr, ATT_LAS const float* bp) {
    if constexpr (BIAS) {
#pragma unroll
        for (int g = 0; g < 4; ++g) { const f32x4 a = *(ATT_LAS const f32x4*)(bp + 8 * g), b = *(ATT_LAS const f32x4*)(bp + 32 + 8 * g);
            p0[4 * g] = a[0]; p0[4 * g + 1] = a[1]; p0[4 * g + 2] = a[2]; p0[4 * g + 3] = a[3]; p1[4 * g] = b[0]; p1[4 * g + 1] = b[1]; p1[4 * g + 2] = b[2]; p1[4 * g + 3] = b[3]; }
    } else { p0 = f32x16{}; p1 = f32x16{}; }
    ATT_LAS const unsigned char* kb[4];
#pragma unroll
    for (int dd = 0; dd < 4; ++dd) kb[dd] = Kt + r32 * (DK * 2) + (((2 * dd + hi) ^ (r32 & 7)) << 4);
#pragma unroll
    for (int d0 = 0; d0 < DK / 16; ++d0) { ATT_LAS const unsigned char* a = kb[d0 & 3] + (d0 >> 2) * 128;
        const bf16x8 b0 = *(ATT_LAS const bf16x8*)a;
        const bf16x8 b1 = *(ATT_LAS const bf16x8*)(a + 32 * DK * 2);
        p0 = __builtin_amdgcn_mfma_f32_32x32x16_bf16(b0, qr[d0], p0, 0, 0, 0);
        p1 = __builtin_amdgcn_mfma_f32_32x32x16_bf16(b1, qr[d0], p1, 0, 0, 0); }
}
template <int DV>
__device__ __forceinline__ void pv_tile(f32x16* o, int vb0, bf16x8 pa0, bf16x8 pa1, bf16x8 pa2, bf16x8 pa3) {
    constexpr int NS = DV / 32, HS = NS * 512, KS = 2 * HS;
#define ATT_TRRD(dst, off) asm volatile("ds_read_b64_tr_b16 %0, %1 offset:%2" : "=&v"(dst) : "v"(vb0), "i"(off) : "memory")
#pragma unroll
    for (int d0 = 0; d0 < NS; ++d0) { s16x4 l0, l1, l2, l3, h0, h1, h2, h3;
        switch (d0) {
        case 0: ATT_TRRD(l0, 0 * 512); ATT_TRRD(h0, 0 * 512 + HS); ATT_TRRD(l1, 0 * 512 + KS); ATT_TRRD(h1, 0 * 512 + KS + HS); ATT_TRRD(l2, 0 * 512 + 2 * KS); ATT_TRRD(h2, 0 * 512 + 2 * KS + HS); ATT_TRRD(l3, 0 * 512 + 3 * KS); ATT_TRRD(h3, 0 * 512 + 3 * KS + HS); break;
        case 1: ATT_TRRD(l0, 1 * 512); ATT_TRRD(h0, 1 * 512 + HS); ATT_TRRD(l1, 1 * 512 + KS); ATT_TRRD(h1, 1 * 512 + KS + HS); ATT_TRRD(l2, 1 * 512 + 2 * KS); ATT_TRRD(h2, 1 * 512 + 2 * KS + HS); ATT_TRRD(l3, 1 * 512 + 3 * KS); ATT_TRRD(h3, 1 * 512 + 3 * KS + HS); break;
        case 2: ATT_TRRD(l0, 2 * 512); ATT_TRRD(h0, 2 * 512 + HS); ATT_TRRD(l1, 2 * 512 + KS); ATT_TRRD(h1, 2 * 512 + KS + HS); ATT_TRRD(l2, 2 * 512 + 2 * KS); ATT_TRRD(h2, 2 * 512 + 2 * KS + HS); ATT_TRRD(l3, 2 * 512 + 3 * KS); ATT_TRRD(h3, 2 * 512 + 3 * KS + HS); break;
        default: ATT_TRRD(l0, 3 * 512); ATT_TRRD(h0, 3 * 512 + HS); ATT_TRRD(l1, 3 * 512 + KS); ATT_TRRD(h1, 3 * 512 + KS + HS); ATT_TRRD(l2, 3 * 512 + 2 * KS); ATT_TRRD(h2, 3 * 512 + 2 * KS + HS); ATT_TRRD(l3, 3 * 512 + 3 * KS); ATT_TRRD(h3, 3 * 512 + 3 * KS + HS); break;
        }
        asm volatile("s_waitcnt lgkmcnt(0)" ::: "memory"); ATT_SBAR();
        o[d0] = __builtin_amdgcn_mfma_f32_32x32x16_bf16(pa0, (bf16x8){l0[0], l0[1], l0[2], l0[3], h0[0], h0[1], h0[2], h0[3]}, o[d0], 0, 0, 0);
        o[d0] = __builtin_amdgcn_mfma_f32_32x32x16_bf16(pa1, (bf16x8){l1[0], l1[1], l1[2], l1[3], h1[0], h1[1], h1[2], h1[3]}, o[d0], 0, 0, 0);
        o[d0] = __builtin_amdgcn_mfma_f32_32x32x16_bf16(pa2, (bf16x8){l2[0], l2[1], l2[2], l2[3], h2[0], h2[1], h2[2], h2[3]}, o[d0], 0, 0, 0);
        o[d0] = __builtin_amdgcn_mfma_f32_32x32x16_bf16(pa3, (bf16x8){l3[0], l3[1], l3[2], l3[3], h3[0], h3[1], h3[2], h3[3]}, o[d0], 0, 0, 0); }
#undef ATT_TRRD
}

template <int KIND>
__device__ __forceinline__ void attn_unit(const Args& T, int b, int h, int qb, ATT_LAS unsigned char* lds) {
    typedef Cfg<KIND> C; constexpr int DK = C::DK, DV = C::DV, QP = C::QP, KP = C::KP, VP = C::VP, NQF = DK / 16, ND = DV / 32;
    constexpr int KBUF = 64 * DK * 2, VBUF = 64 * DV * 2;
    int tid_l = threadIdx.x; asm volatile("" : "+v"(tid_l));
    const int tid = tid_l, wid = __builtin_amdgcn_readfirstlane(tid >> 6), lane = tid & 63, r32 = lane & 31, hi = lane >> 5;
    const int P0 = qb * QB, kvh = h / C::G;
    const size_t tok0 = (size_t)b * SEQ;
    const int j_lo = (KIND == 1 && P0 >= QB) ? (P0 - 128) / KVBLK : 0, j_hi = (P0 + QB) / KVBLK;
    const int qlo = P0 + wid * 32, qpos = qlo + r32;
    ATT_LAS unsigned char* K_lds = lds + L_K; ATT_LAS unsigned char* V_lds = lds + L_V;
    ATT_LAS float* wsf = (ATT_LAS float*)(lds + L_WS) + wid * 64; ATT_LAS float* li_l = wsf; ATT_LAS float* al_l = wsf + 32;
    ATT_LAS float* tab = (ATT_LAS float*)(lds + L_TAB);
    const int vb0 = (int)(unsigned)(uintptr_t)V_lds + v_rd_base(lane);
    const bf16_t* Kg = T.K + tok0 * KP + kvh * (KIND == 0 ? 128 : DK);
    const bf16_t* Vg = T.V + tok0 * VP + kvh * DV;
    const bf16_t* KRg = T.KR + tok0 * 64;
    bf16x8 stK[3], stV[2];
    const int sr = tid >> 4, sc = tid & 15, sr8 = tid >> 3, sc8 = tid & 7;
#define ATT_SLOAD(kb_) do { \
        if constexpr (KIND == 1) { stK[0] = *(const bf16x8*)(Kg + (size_t)((kb_) + sr8) * KP + sc8 * 8); stV[0] = *(const bf16x8*)(Vg + (size_t)((kb_) + sr8) * VP + sc8 * 8); } \
        else { stK[0] = *(const bf16x8*)(Kg + (size_t)((kb_) + sr) * KP + sc * 8); stK[1] = *(const bf16x8*)(Kg + (size_t)((kb_) + 32 + sr) * KP + sc * 8); \
               stV[0] = *(const bf16x8*)(Vg + (size_t)((kb_) + sr) * VP + sc * 8); stV[1] = *(const bf16x8*)(Vg + (size_t)((kb_) + 32 + sr) * VP + sc * 8); \
               if constexpr (KIND == 0) stK[2] = *(const bf16x8*)(KRg + (size_t)((kb_) + sr8) * 64 + sc8 * 8); } } while (0)
#define ATT_SWRITE(bf) do { \
        if constexpr (KIND == 1) { *(ATT_LAS bf16x8*)(K_lds + (bf) * KBUF + k_st<DK>(sr8, sc8)) = stK[0]; *(ATT_LAS bf16x8*)(V_lds + (bf) * VBUF + v_st<DV>(sr8, sc8 * 8)) = stV[0]; } \
        else { *(ATT_LAS bf16x8*)(K_lds + (bf) * KBUF + k_st<DK>(sr, sc)) = stK[0]; *(ATT_LAS bf16x8*)(K_lds + (bf) * KBUF + k_st<DK>(32 + sr, sc)) = stK[1]; \
               *(ATT_LAS bf16x8*)(V_lds + (bf) * VBUF + v_st<DV>(sr, sc * 8)) = stV[0]; *(ATT_LAS bf16x8*)(V_lds + (bf) * VBUF + v_st<DV>(32 + sr, sc * 8)) = stV[1]; \
               if constexpr (KIND == 0) *(ATT_LAS bf16x8*)(K_lds + (bf) * KBUF + k_st<DK>(sr8, 16 + sc8)) = stK[2]; } } while (0)
    ATT_SLOAD(j_lo * KVBLK);
    bf16x8 qr[NQF];
    { const bf16_t* Qw = T.Q + (tok0 + qpos) * QP + h * DK + hi * 8;
#pragma unroll
      for (int d0 = 0; d0 < NQF; ++d0) qr[d0] = *(const bf16x8*)(Qw + d0 * 16); }
    float m_reg = -1e30f, l_reg = 0.f;
    if constexpr (KIND == 2) { const float* cb = T.CB + ((size_t)b * 16 + h) * SEQ; for (int i = tid; i < P0 + QB; i += 512) tab[i] = cb[i]; }
    if constexpr (KIND == 1) {
        for (int j = tid; j < 640; j += 512) { const int d = 383 - j; float v = 0.f;
            if (d >= 0 && d < 128) { int bk = d; if (d >= 16) { bk = 16 + (int)(__logf((float)d * (1.0f / 16.0f)) / 2.0794415416798357f * 16.0f); bk = bk > 31 ? 31 : bk; } v = T.relt[bk * 32 + h] * LOG2E; }
            tab[j] = v; }
        m_reg = T.sinks[h] * LOG2E; l_reg = 1.f; }
    f32x16 o[ND];
#pragma unroll
    for (int d = 0; d < ND; ++d) o[d] = f32x16{};
    asm volatile("s_waitcnt vmcnt(0)" ::: "memory");
    ATT_SWRITE(0);
    __syncthreads();
    for (int t = j_lo; t < j_hi; ++t) {
        const int bf = (t - j_lo) & 1, kb = t * KVBLK;
        if (t + 1 < j_hi) ATT_SLOAD(kb + KVBLK);
        ATT_SBAR();
        bool act = kb <= qlo + 31; if constexpr (KIND == 1) act = act && (kb + KVBLK - 1 >= qlo - 127);
        if (act) {
            f32x16 p0, p1;
            qkt<DK, KIND == 2>(p0, p1, K_lds + bf * KBUF, r32, hi, qr, tab + kb + 4 * hi);
            const int dq = qpos - kb - 4 * hi;
            if constexpr (KIND == 1) {
                ATT_LAS const float* tp = tab + (383 - dq);
#pragma unroll
                for (int r = 0; r < 16; ++r) { const int c = (r & 3) + 8 * (r >> 2); p0[r] += tp[c]; p1[r] += tp[c + 32]; }
            }
            if (KIND == 1 || kb + KVBLK - 1 > qlo) {
                const unsigned W = KIND == 1 ? 128u : 0x7fffffffu; const float NEG = -__builtin_inff();
#pragma unroll
                for (int r = 0; r < 16; ++r) { const int c = (r & 3) + 8 * (r >> 2);
                    if ((unsigned)(dq - c) >= W) p0[r] = NEG;
                    if ((unsigned)(dq - c - 32) >= W) p1[r] = NEG; }
            }
            float pmax = p0[0];
#pragma unroll
            for (int r = 1; r < 16; ++r) pmax = fmaxf(pmax, p0[r]);
#pragma unroll
            for (int r = 0; r < 16; ++r) pmax = fmaxf(pmax, p1[r]);
            { auto rr = __builtin_amdgcn_permlane32_swap(__float_as_uint(pmax), __float_as_uint(pmax), false, false);
              pmax = fmaxf(__uint_as_float(rr[0]), __uint_as_float(rr[1])); }
            const float mn = fmaxf(m_reg, pmax);
            const float alpha = __builtin_amdgcn_exp2f(m_reg - mn);
            m_reg = mn;
            float ps = 0.f;
#pragma unroll
            for (int r = 0; r < 16; ++r) { p0[r] = __builtin_amdgcn_exp2f(p0[r] - mn); ps += p0[r]; }
#pragma unroll
            for (int r = 0; r < 16; ++r) { p1[r] = __builtin_amdgcn_exp2f(p1[r] - mn); ps += p1[r]; }
            { auto rr = __builtin_amdgcn_permlane32_swap(__float_as_uint(ps), __float_as_uint(ps), false, false);
              ps = __uint_as_float(rr[0]) + __uint_as_float(rr[1]); }
            l_reg = l_reg * alpha + ps;
            if (__any(alpha < 1.f)) {
                if (hi == 0) al_l[r32] = alpha;
                asm volatile("s_waitcnt lgkmcnt(0)" ::: "memory");
#pragma unroll
                for (int g = 0; g < 4; ++g) { const f32x4 a4 = *(ATT_LAS const f32x4*)(al_l + 8 * g + 4 * hi);
#pragma unroll
                    for (int d = 0; d < ND; ++d) { o[d][4 * g] *= a4[0]; o[d][4 * g + 1] *= a4[1]; o[d][4 * g + 2] *= a4[2]; o[d][4 * g + 3] *= a4[3]; } }
            }
            bf16x8 pa0, pa1, pa2, pa3;
#define ATT_PK4(P, B_, OUT) do { unsigned a0 = cvtpk(P[B_ + 0], P[B_ + 1]), a1 = cvtpk(P[B_ + 2], P[B_ + 3]); \
            unsigned b0 = cvtpk(P[B_ + 4], P[B_ + 5]), b1 = cvtpk(P[B_ + 6], P[B_ + 7]); \
            auto r0 = __builtin_amdgcn_permlane32_swap(a0, b0, false, false); auto r1 = __builtin_amdgcn_permlane32_swap(a1, b1, false, false); \
            u32x4 w = {r0[0], r1[0], r0[1], r1[1]}; OUT = __builtin_bit_cast(bf16x8, w); } while (0)
            ATT_PK4(p0, 0, pa0); ATT_PK4(p0, 8, pa1); ATT_PK4(p1, 0, pa2); ATT_PK4(p1, 8, pa3);
#undef ATT_PK4
            pv_tile<DV>(o, vb0 + bf * VBUF, pa0, pa1, pa2, pa3);
        }
        ATT_SBAR();
        if (t + 1 < j_hi) { asm volatile("s_waitcnt vmcnt(0)" ::: "memory"); ATT_SWRITE(bf ^ 1); }
        __syncthreads();
    }
    if (hi == 0) li_l[r32] = l_reg;
    asm volatile("s_waitcnt lgkmcnt(0)" ::: "memory");
    const size_t orow0 = (tok0 + P0 + wid * 32) * 2048 + (size_t)h * DV + r32;
#pragma unroll
    for (int g = 0; g < 4; ++g) { const f32x4 l4 = *(ATT_LAS const f32x4*)(li_l + 8 * g + 4 * hi);
#pragma unroll
        for (int e = 0; e < 4; ++e) { const int r = 4 * g + e; const float rl = __builtin_amdgcn_rcpf(l4[e]); const size_t ro = orow0 + (size_t)(8 * g + 4 * hi + e) * 2048;
#pragma unroll
            for (int d0 = 0; d0 < ND; ++d0) { const float z = __uint_as_float((unsigned)T.Z[ro + d0 * 32] << 16);
                const float v = o[d0][r] * rl * z * __builtin_amdgcn_rcpf(1.0f + __builtin_amdgcn_exp2f(-LOG2E * z));
                const float vn = __shfl_xor(v, 1);
                if ((r32 & 1) == 0) *(unsigned*)(T.O + ro + d0 * 32) = cvtpk(v, vn); } } }
    __syncthreads();
#undef ATT_SLOAD
#undef ATT_SWRITE
}
}
static_assert(att::L_END <= RING_BYTES, "attention LDS inside the ring region");

struct Args { const void* in[18]; float* out; unsigned char* ws; };
#ifndef PH_MASK
#define PH_MASK 0xffff
#endif
#define PH(k) ((PH_MASK >> (k)) & 1)

__device__ __forceinline__ float wave_sum(float v) {
#pragma unroll
    for (int o = 1; o < 64; o <<= 1) v += __shfl_xor(v, o);
    return v;
}
__device__ __forceinline__ int ropeidx(int p) { const int j = p >> 3, e = p & 7; return e < 4 ? 4 * j + e : 32 + 4 * j + (e - 4); }

struct CvtJob { const float* W; const float* W2; const float* gain; bf16* WT; int K, N, N2, kind; };
__device__ __forceinline__ void cvt_item(const CvtJob& J, LAS float* scr, int item, int lane, int nblk) {
    const int kb = item / nblk, nb = item - kb * nblk, k0 = 64 * kb, n0 = 32 * nb;
    const int n = n0 + (lane & 31);
    const float* src = J.W; int col = n, ld = J.N;
    if (J.kind == 0) {
        if (n < 2048) col = n; else if (n < 14848) col = n + 64; else if (n < 16896) col = n + 80;
        else if (n < 17152) { const int lc = n - 16896; col = lc < 64 ? 2048 + ropeidx(lc) : (lc < 80 ? 14912 + (lc - 64) : -1); }
        else { src = J.W2; col = n - 17152; ld = J.N2; }
    } else if (J.kind == 1) { const int hh = n / 192, c = n - hh * 192; col = hh * 192 + (c < 128 ? c : 128 + ropeidx(c - 128)); }
    else if (J.kind == 2) { if (n >= 2048) { src = J.W2; col = n - 2048; } }
#pragma unroll 8
    for (int i = 0; i < 32; ++i) { const int kk = 2 * i + (lane >> 5); float v = 0.f; if (col >= 0) v = src[(size_t)(k0 + kk) * ld + col]; if (J.gain) v *= J.gain[k0 + kk]; scr[kk * 33 + (lane & 31)] = v; }
    LDS_WAIT(); asm volatile("" ::: "memory");
    const int c = lane & 7;
#pragma unroll
    for (int j = 0; j < 4; ++j) { const int nn = (lane >> 3) + 8 * j; const LAS float* s = scr + (8 * c) * 33 + nn;
        v4u o; o.x = pk2(s[0 * 33], s[1 * 33]); o.y = pk2(s[2 * 33], s[3 * 33]); o.z = pk2(s[4 * 33], s[5 * 33]); o.w = pk2(s[6 * 33], s[7 * 33]);
        *(GAS v4u*)(J.WT + (size_t)(n0 + nn) * J.K + k0 + 8 * c) = o; }
    LDS_WAIT(); asm volatile("" ::: "memory");
}
__device__ __forceinline__ void cvt_job(const CvtJob& J, int ndst, LAS float* scr, int gw, int ngw, int lane) {
    const int nblk = ndst / 32, nitems = (J.K / 64) * nblk;
    for (int it = gw; it < nitems; it += ngw) cvt_item(J, scr, it, lane, nblk);
}

__device__ __forceinline__ void rms_store_bf16(const f32x4 (&v)[16], const float* g, bf16* orow, int lane) {
    float s = 0.f;
#pragma unroll
    for (int j = 0; j < 16; ++j) s += (v[j].x * v[j].x + v[j].y * v[j].y) + (v[j].z * v[j].z + v[j].w * v[j].w);
    const float rs = 1.0f / sqrtf(wave_sum(s) * (1.0f / DM) + 1e-6f);
    GAS unsigned long long* o8 = (GAS unsigned long long*)orow + lane;
#pragma unroll
    for (int j = 0; j < 16; ++j) { const f32x4 gg = *((const GAS f32x4*)g + lane + 64 * j);
        o8[64 * j] = (unsigned long long)pk2(v[j].x * rs * gg.x, v[j].y * rs * gg.y) | ((unsigned long long)pk2(v[j].z * rs * gg.z, v[j].w * rs * gg.w) << 32); }
}

#define KAS __attribute__((address_space(4)))
#define KARG(k) ({ const KAS char* kp_ = (const KAS char*)__builtin_amdgcn_kernarg_segment_ptr(); asm volatile("" : "+s"(kp_)); *(const void* const KAS*)(kp_ + 8 * (k)); })
#define IN_F(k) ((const float*)KARG(k))
#define WSP ((unsigned char*)KARG(19))
__global__ void __launch_bounds__(NWAVES * 64, 2) mk_fwd(Args args) {
    extern __shared__ __attribute__((aligned(16))) unsigned char lds_raw[];
    LAS unsigned char* lds = (LAS unsigned char*)lds_raw;
    volatile LAS unsigned* MISC = (volatile LAS unsigned*)(lds + MISC_OFF);
    const int G = gridDim.x, bx = blockIdx.x, vcu = (G % 8 == 0) ? (bx % 8) * (G / 8) + bx / 8 : bx;
    for (int u = threadIdx.x; u < (LDS_BYTES - LDSCTL_OFF) / 4; u += NWAVES * 64) ((LAS unsigned*)(lds + LDSCTL_OFF))[u] = 0u;
    __syncthreads();
    XcdBarrier bar = xcd_barrier_post((unsigned*)((gu32*)(WSP + WS_CTL) + CW_BAR), MISC + 8);
    const int NGW = G * NWAVES;
#define PHASE_LOCALS() int tid_l = threadIdx.x; asm volatile("" : "+v"(tid_l)); const int tid = tid_l, lane = tid & 63, wave = __builtin_amdgcn_readfirstlane(tid >> 6), gw = vcu * NWAVES + wave; unsigned char* ws = WSP; (void)lane; (void)gw; (void)ws

    if (PH(0)) {
        PHASE_LOCALS();
        LAS float* scr = (LAS float*)(lds + RING_OFF + wave * 16384);
        for (int l = 0; l < 2; ++l) {
            unsigned char* wl = ws + WS_W + (size_t)l * W_LAYER;
            { CvtJob J{IN_F(4) + (size_t)l * DM * NIN, IN_F(15) + (size_t)l * DM * NMRG, nullptr, (bf16*)(wl + W_BIG), DM, NIN, NMRG, 0}; cvt_job(J, NBIG, scr, gw, NGW, lane); }
            { CvtJob J{IN_F(7) + (size_t)l * 1536 * 3072, nullptr, IN_F(5) + l * 1536, (bf16*)(wl + W_UQ), 1536, 3072, 0, 1}; cvt_job(J, 3072, scr, gw, NGW, lane); }
            { CvtJob J{IN_F(8) + (size_t)l * 512 * 2048, IN_F(9) + (size_t)l * 512 * 2048, IN_F(6) + l * 512, (bf16*)(wl + W_UKV), 512, 2048, 2048, 2}; cvt_job(J, 4096, scr, gw, NGW, lane); }
            { CvtJob J{IN_F(12) + (size_t)l * 2048 * DM, nullptr, nullptr, (bf16*)(wl + W_PROJ), 2048, DM, 0, 3}; cvt_job(J, DM, scr, gw, NGW, lane); }
            { CvtJob J{IN_F(13) + (size_t)l * 2048 * DM, nullptr, nullptr, (bf16*)(wl + W_PROJ) + (size_t)DM * 2048, 2048, DM, 0, 3}; cvt_job(J, DM, scr, gw, NGW, lane); }
            { CvtJob J{IN_F(14) + (size_t)l * 2048 * DM, nullptr, nullptr, (bf16*)(wl + W_PROJ) + (size_t)2 * DM * 2048, 2048, DM, 0, 3}; cvt_job(J, DM, scr, gw, NGW, lane); }
            { CvtJob J{IN_F(16) + (size_t)l * DM * DM, nullptr, nullptr, (bf16*)(wl + W_O), DM, DM, 0, 3}; cvt_job(J, DM, scr, gw, NGW, lane); }
        }
        { float* ropeC = (float*)(ws + WS_ROPEC); float* ropeS = (float*)(ws + WS_ROPES); const int* positions = (const int*)KARG(1);
          for (int i = bx * 512 + tid; i < M * 32; i += G * 512) { const int m = i >> 5, k = i & 31;
            const float inv = exp2f(-(float)k * (13.287712379549449f / 32.0f));
            const float ang = (float)positions[m] * inv; float s, c; sincosf(ang, &s, &c); ropeC[i] = c; ropeS[i] = s; }
          float* RS = (float*)(ws + WS_RS);
          for (int i = bx * 512 + tid; i < 4 * M; i += G * 512) RS[i] = 0.f; }
        { const float* x_in = IN_F(0); const float* pre_norm = IN_F(3); bf16* Hb = (bf16*)(ws + WS_H);
          for (int m = gw; m < M; m += NGW) { f32x4 v[16]; const GAS f32x4* xr = (const GAS f32x4*)(x_in + (size_t)m * DM) + lane;
#pragma unroll
            for (int j = 0; j < 16; ++j) v[j] = xr[64 * j];
            rms_store_bf16(v, pre_norm, Hb + (size_t)m * DM, lane); } }
    }
    xcd_barrier(bar);

    for (int l = 0; l < 2; ++l) {
        if (PH(2)) {
            unsigned char* ws = WSP; unsigned char* wl = ws + WS_W + (size_t)l * W_LAYER;
            pg8::Gemm g{(const bf16*)(ws + WS_H), (const bf16*)(wl + W_BIG), M, NBIG, DM}; pg8::StaticOrder S; S.init(M, NBIG, G, bx);
            pg8::EpiBig E{ws, IN_F(11) + l * 16, l};
            pg8::gemm_phase<pg8::EpiBig, pg8::StaticOrder, true, true>(lds + RING_OFF, g, S, E);
        }
        xcd_barrier(bar);
        if (PH(3) && vcu < 128) {
            PHASE_LOCALS();
            const int b = vcu >> 4, hh = vcu & 15; const float* lf = (const float*)(ws + WS_LOGF) + (size_t)b * SEQ * 16 + hh;
            float v0 = lf[(size_t)(4 * tid) * 16], v1 = lf[(size_t)(4 * tid + 1) * 16], v2 = lf[(size_t)(4 * tid + 2) * 16], v3 = lf[(size_t)(4 * tid + 3) * 16];
            v1 += v0; v2 += v1; v3 += v2;
            float inc = v3;
#pragma unroll
            for (int o = 1; o < 64; o <<= 1) { const float t = __shfl_up(inc, o); if (lane >= o) inc += t; }
            LAS float* wsum = (LAS float*)(lds + RING_OFF);
            if (lane == 63) wsum[wave] = inc;
            __syncthreads();
            float base = inc - v3;
            for (int w = 0; w < wave; ++w) base += wsum[w];
            float* cb = (float*)(ws + WS_CB) + ((size_t)b * 16 + hh) * SEQ + 4 * tid;
            *(f32x4*)cb = (f32x4){-(base + v0) * LOG2E_F, -(base + v1) * LOG2E_F, -(base + v2) * LOG2E_F, -(base + v3) * LOG2E_F};
            __syncthreads();
        }
        if (PH(3)) {
            unsigned char* ws = WSP; unsigned char* wl = ws + WS_W + (size_t)l * W_LAYER;
            pg8::Gemm g{(const bf16*)(ws + WS_ACQ), (const bf16*)(wl + W_UQ), M, 3072, 1536}; pg8::StaticOrder S; S.init(M, 3072, G, bx);
            pg8::EpiQA E{ws, l};
            pg8::gemm_phase<pg8::EpiQA, pg8::StaticOrder, true, true>(lds + RING_OFF, g, S, E);
        }
        if (PH(4)) {
            unsigned char* ws = WSP; unsigned char* wl = ws + WS_W + (size_t)l * W_LAYER;
            pg8::Gemm g{(const bf16*)(ws + WS_ACKV), (const bf16*)(wl + W_UKV), M, 4096, 512}; pg8::StaticOrder S; S.init(M, 4096, G, bx);
            pg8::EpiKV E{ws, l};
            pg8::gemm_phase<pg8::EpiKV, pg8::StaticOrder, true, true>(lds + RING_OFF, g, S, E);
        }
        xcd_barrier(bar);
        if (PH(5)) { unsigned char* ws = WSP;
            att::Args TA{(const bf16*)(ws + WS_QA), (const bf16*)(ws + WS_KA), (const bf16*)(ws + WS_KR), (const bf16*)(ws + WS_VA), (const bf16*)(ws + WS_AZ), (bf16*)(ws + WS_OCAT), nullptr, nullptr, nullptr};
            for (int e = vcu * 4; e < 1024; e += ((e & 3) == 3) ? G * 4 - 3 : 1) { const int uu = e >> 1, bh = uu >> 2, pr = uu & 3;
                att::attn_unit<0>(TA, bh >> 4, bh & 15, (e & 1) ? pr : 7 - pr, lds + RING_OFF); }
        }
        if (PH(6)) { unsigned char* ws = WSP;
            att::Args TC{(const bf16*)(ws + WS_CQ), (const bf16*)(ws + WS_CK), nullptr, (const bf16*)(ws + WS_CV), (const bf16*)(ws + WS_CZ), (bf16*)(ws + WS_OCAT) + (size_t)2 * M * 2048, (const float*)(ws + WS_CB), nullptr, nullptr};
            for (int e = vcu * 4; e < 1024; e += ((e & 3) == 3) ? G * 4 - 3 : 1) { const int uu = e >> 1, bh = uu >> 2, pr = uu & 3;
                att::attn_unit<2>(TC, bh >> 4, bh & 15, (e & 1) ? pr : 7 - pr, lds + RING_OFF); }
        }
        if (PH(7)) { unsigned char* ws = WSP;
            att::Args TB{(const bf16*)(ws + WS_BQ), (const bf16*)(ws + WS_BK), nullptr, (const bf16*)(ws + WS_BV), (const bf16*)(ws + WS_BZ), (bf16*)(ws + WS_OCAT) + (size_t)M * 2048, nullptr, IN_F(2), IN_F(10) + l * 32};
            for (int e = vcu * 8; e < 2048; e += ((e & 7) == 7) ? G * 8 - 7 : 1) { const int bh = e >> 3;
                att::attn_unit<1>(TB, bh >> 5, bh & 31, e & 7, lds + RING_OFF); }
        }
        xcd_barrier(bar);
        if (PH(8)) {
            unsigned char* ws = WSP; unsigned char* wl = ws + WS_W + (size_t)l * W_LAYER;
            pg8::Gemm g{(const bf16*)(ws + WS_OCAT), (const bf16*)(wl + W_PROJ), 3 * M, 3 * DM, 2048}; pg8::GateOrder S; S.S.init(M, DM, G, bx);
            pg8::EpiGate E{ws};
            pg8::gemm_phase<pg8::EpiGate, pg8::GateOrder, true, true>(lds + RING_OFF, g, S, E);
        }
        xcd_barrier(bar);
        if (PH(9)) {
            unsigned char* ws = WSP; unsigned char* wl = ws + WS_W + (size_t)l * W_LAYER;
            pg8::Gemm g{(const bf16*)(ws + WS_Y), (const bf16*)(wl + W_O), M, DM, DM}; pg8::StaticOrder S; S.init(M, DM, G, bx);
            pg8::EpiF32 E{(float*)(ws + WS_Z), DM};
            pg8::gemm_phase<pg8::EpiF32, pg8::StaticOrder, true, true>(lds + RING_OFF, g, S, E);
        }
        xcd_barrier(bar);
        if (PH(10)) {
            PHASE_LOCALS();
            bf16* Hb = (bf16*)(ws + WS_H);
            const float* pg = IN_F(17) + l * DM; float* xo = (float*)KARG(18); const float* x_res = l == 0 ? IN_F(0) : (const float*)xo; const float* pre1 = IN_F(3) + DM;
            for (int m = gw; m < M; m += NGW) { f32x4 v[16]; const GAS f32x4* zr = (const GAS f32x4*)((const float*)(ws + WS_Z) + (size_t)m * DM) + lane;
                float s = 0.f;
#pragma unroll
                for (int j = 0; j < 16; ++j) { v[j] = zr[64 * j]; s += (v[j].x * v[j].x + v[j].y * v[j].y) + (v[j].z * v[j].z + v[j].w * v[j].w); }
                const float rs = 1.0f / sqrtf(wave_sum(s) * (1.0f / DM) + 1e-6f);
                const GAS f32x4* xr = (const GAS f32x4*)(x_res + (size_t)m * DM) + lane; GAS f32x4* orow = (GAS f32x4*)(xo + (size_t)m * DM) + lane;
#pragma unroll
                for (int j = 0; j < 16; ++j) { const f32x4 gg = *((const GAS f32x4*)pg + lane + 64 * j); v[j] = xr[64 * j] + v[j] * rs * gg; orow[64 * j] = v[j]; }
                if (l == 0) rms_store_bf16(v, pre1, Hb + (size_t)m * DM, lane); }
        }
        if (l == 0) xcd_barrier(bar);
    }
}

extern "C" void kernel_launch(void* const* d_in, const int* in_sizes, int n_in, void* d_out, int out_size, void* d_ws, size_t ws_size, hipStream_t stream) {
    static int grid = 0;
    if (grid == 0) {
        if (n_in != 18 || out_size != M * DM || ws_size < WS_END) { fprintf(stderr, "kernel_launch: unexpected shapes (n_in %d out %d ws %zu)\n", n_in, out_size, ws_size); grid = -1; return; }
        int dev = 0, cus = 0, per_cu = 0;
        if (hipGetDevice(&dev) != hipSuccess || hipDeviceGetAttribute(&cus, hipDeviceAttributeMultiprocessorCount, dev) != hipSuccess) { grid = -1; return; }
        if (hipFuncSetAttribute((const void*)mk_fwd, hipFuncAttributeMaxDynamicSharedMemorySize, LDS_BYTES) != hipSuccess) { fprintf(stderr, "kernel_launch: hipFuncSetAttribute failed\n"); grid = -1; return; }
        if (hipOccupancyMaxActiveBlocksPerMultiprocessor(&per_cu, (const void*)mk_fwd, NWAVES * 64, LDS_BYTES) != hipSuccess || per_cu < 1)
            fprintf(stderr, "kernel_launch: note: occupancy query reports %d workgroups per CU\n", per_cu);
        (void)hipGetLastError();
        grid = cus;
    }
    if (grid < 0) return;
    if (hipMemsetAsync((char*)d_ws + WS_CTL, 0, CTL_ZERO_BYTES, stream) != hipSuccess) return;
    Args a{};
    for (int i = 0; i < 18; ++i) a.in[i] = d_in[i];
    a.out = (float*)d_out; a.ws = (unsigned char*)d_ws;
    hipLaunchKernelGGL(mk_fwd, dim3(grid), dim3(NWAVES * 64), LDS_BYTES, stream, a);
}
```

```cpp
#include <hip/hip_runtime.h>
#include <cstdio>
#include <cstdint>
#include <cmath>
#ifndef GALIGN
#define GALIGN true
#endif
#ifndef P2B_ALIGN
#define P2B_ALIGN true
#endif
#ifndef P2B_SP2
#define P2B_SP2 true
#endif
#ifndef GATE_DESCALE
#define GATE_DESCALE 0.015625f
#endif
#ifndef TEST_ASM_BF16
#define TEST_ASM_BF16 false
#endif
#ifndef TEST_FP8_FLAG
#define TEST_FP8_FLAG true
#endif
constexpr int NWAVES = 8;
constexpr int M_ROWS = 16384, NBIG_COLS = 26368;
constexpr int M = 16384, DM = 4096, SEQ = 2048, NBATCH = 8, NBIG = 29440, N8 = 26368  , N16 = 3072  , NIN = 16976, NMRG = 12288;
constexpr float LOG2E_F = 1.4426950408889634f;
constexpr float QS_A = 0.07216878364870323f * LOG2E_F;
constexpr float QS_B = 0.125f * LOG2E_F;
constexpr float QS_C = 0.08838834764831845f * LOG2E_F;
constexpr size_t MiB = 1u << 20;
constexpr size_t WS_CTL = 0, CTL_ZERO_BYTES = 1 * MiB;
constexpr size_t WS_W = 2 * MiB, W_LAYER = 323 * MiB, W_BIG = 0  , W_BIG16 = 104 * MiB  , W_UQ = 230 * MiB, W_UKV = 239 * MiB, W_PROJ = 243 * MiB, W_O = 291 * MiB;
constexpr size_t WS_H = 648 * MiB, WS_ACQ = 776 * MiB, WS_ACKV = 824 * MiB, WS_QA = 840 * MiB, WS_KA = 936 * MiB, WS_VA = 1000 * MiB, WS_AZ = 1064 * MiB,
                 WS_CQ = 1128 * MiB, WS_CK = 1192 * MiB, WS_CV = 1256 * MiB, WS_CZ = 1320 * MiB, WS_BQ = 1384 * MiB, WS_BZ = 1448 * MiB, WS_BK = 1512 * MiB, WS_BV = 1520 * MiB,
                 WS_KR = 1528 * MiB, WS_LOGF = 1530 * MiB, WS_CB = 1531 * MiB, WS_RS = 1532 * MiB, WS_ROPEC = 1533 * MiB, WS_ROPES = 1535 * MiB, WS_GATES = 1538 * MiB,
                 WS_OCAT = WS_H, WS_YACC = WS_QA, WS_Y = WS_CQ, WS_Z = WS_GATES, WS_H8 = 1922 * MiB  , WS_END = 1986 * MiB;
constexpr size_t WS_SA = WS_RS + 512 * 1024  , WS_SB = WS_RS + 576 * 1024  , WS_CMAX = WS_CTL + 65536  ;
constexpr int CW_TMO = 0, CW_BAR = 4096;
constexpr int RING_OFF = 0, RING_BYTES = 131072, LDS_BYTES = 147456, LDSCTL_OFF = LDS_BYTES - 1024  , MISC_OFF = LDSCTL_OFF + 320;
namespace pg8 {
#define PG8_LAS __attribute__((address_space(3)))
typedef unsigned short bf16_t;
typedef short bf16x8 __attribute__((ext_vector_type(8)));
typedef float f32x4 __attribute__((ext_vector_type(4)));
typedef unsigned u32x4 __attribute__((ext_vector_type(4)));
constexpr int BM = 256, BK = 64, HALF = 128, HTB = HALF * BK * 2  , STAGE_BYTES = 8 * HTB, NXCD = 8, WGM = 8;

__host__ __device__ __forceinline__ int lds_byte(int r, int c) { const int st = (r >> 4) * 2 + (c >> 5), rr = r & 15, cc = c & 31, ob = rr * 64 + cc * 2; return st * 1024 + (ob ^ (((ob >> 9) & 1) << 5)); }
__host__ __device__ __forceinline__ void stage_rc(int b, int& R, int& C) { const int st = b / 1024, sb = b % 1024, swz = sb ^ (((sb >> 9) & 1) << 5); R = (st >> 1) * 16 + swz / 64; C = (st & 1) * 32 + (swz % 64) / 2; }
__host__ __device__ __forceinline__ int perm32(int rho) { const int n = rho >> 4, i = rho & 15; return 8 * (i >> 2) + 4 * n + (i & 3); }

struct Unit { int pm, pn; };
struct Gemm { const bf16_t* A; const bf16_t* Bt; int M, N, K; int aktm; };

struct StaticOrder {
    int nM, nN, nwg, G, c;
    __host__ __device__ void init(int M, int N, int G_, int c_) { nM = M / BM; nN = N / BM; nwg = nM * nN; G = G_; c = c_; }
    __host__ __device__ bool next(int i, Unit& u) const {
        const long L = (long)i * G + c; if (L >= nwg) return false;
        int wgid = (int)L; { const int q = nwg / NXCD, r = nwg % NXCD, xcd = wgid % NXCD, off = wgid / NXCD; wgid = (xcd < r ? xcd * (q + 1) : r * (q + 1) + (xcd - r) * q) + off; }
        const int nig = WGM * nN, gid = wgid / nig, fm = gid * WGM, gsz = (nM - fm) < WGM ? (nM - fm) : WGM;
        u.pm = fm + ((wgid % nig) % gsz); u.pn = (wgid % nig) / gsz; return true;
    }
    __device__ __forceinline__ void a_ready(const Unit&) const {}
    __device__ __forceinline__ void done(const Unit&) const {}
};

typedef float pg8_f32x2 __attribute__((ext_vector_type(2))); typedef __bf16 pg8_bf16x2 __attribute__((ext_vector_type(2)));
__device__ __forceinline__ unsigned cvt_pk_bf16(float lo, float hi) { const pg8_f32x2 v = {lo, hi}; const pg8_bf16x2 b = __builtin_convertvector(v, pg8_bf16x2); return __builtin_bit_cast(unsigned, b); }
__device__ __forceinline__ float bf_lo(unsigned w) { return __uint_as_float(w << 16); }
__device__ __forceinline__ float bf_hi(unsigned w) { return __uint_as_float(w & 0xffff0000u); }
__device__ __forceinline__ float sigmoidf_(float v) { return __builtin_amdgcn_rcpf(1.0f + __builtin_amdgcn_exp2f(-1.4426950408889634f * v)); }
__device__ __forceinline__ u32x4 pack8(f32x4 a, f32x4 b) { u32x4 w; w.x = cvt_pk_bf16(a[0], a[1]); w.y = cvt_pk_bf16(a[2], a[3]); w.z = cvt_pk_bf16(b[0], b[1]); w.w = cvt_pk_bf16(b[2], b[3]); return w; }

__device__ __forceinline__ size_t gate_slot(int tile, int ai, int m, int bj, int wave, int lane) { return (size_t)tile * 8192 + (size_t)((((ai * 4 + m) * 2 + bj) * 8 + wave) * 64 + lane); }
template <bool I8> struct EpiBig {
    static constexpr bool PERM = true, AFTER_DRAIN = false, ASM_MMA = false, MIDK = false;
    unsigned char* ws;
    const float* bfp;
    int layer;
    __device__ __forceinline__ void operator()(const f32x4 (&acc)[2][2][4][2], const Unit& u, int wr, int wc, int fr_in, int fq_in) const {
        int fr = fr_in, fq = fq_in; asm volatile("" : "+v"(fr), "+v"(fq));
        unsigned long long* rsq = (unsigned long long*)(ws + WS_RS) + (size_t)layer * 2 * M_ROWS; unsigned long long* rskv = rsq + M_ROWS;
        const float* ropeC = (const float*)(ws + WS_ROPEC); const float* ropeS = (const float*)(ws + WS_ROPES);
        const int pn = u.pn;
        const int row0 = u.pm * BM + wr * 64 + fr;
        const int lc0 = wc * 32 + 8 * fq;
        const float* SA = (const float*)(ws + WS_SA);
        f32x4 sbv[2][2];
        if constexpr (I8) { const float* SBp = (const float*)(ws + WS_SB) + (size_t)layer * NBIG_COLS + pn * BM + lc0;
#pragma unroll
            for (int bj = 0; bj < 2; ++bj) { sbv[bj][0] = *(const f32x4*)(SBp + bj * HALF); sbv[bj][1] = *(const f32x4*)(SBp + bj * HALF + 4); } }
#define DEQ(ai_, bj_, m_, n_, sa_) ({ f32x4 t_; if constexpr (I8) { _Pragma("unroll") for (int e_ = 0; e_ < 4; ++e_) t_[e_] = (float)__float_as_int(acc[ai_][bj_][m_][n_][e_]) * (sa_) * sbv[bj_][n_][e_]; } else t_ = acc[ai_][bj_][m_][n_]; t_; })
        if (!I8 && pn == 11) {
            if (lc0 < 64) {
                const int i0 = (lc0 >> 3) * 4;
#pragma unroll
                for (int ai = 0; ai < 2; ++ai)
#pragma unroll
                    for (int m = 0; m < 4; ++m) { const int row = row0 + ai * HALF + m * 16;
                        const f32x4 c = *(const f32x4*)(ropeC + (size_t)row * 32 + i0), s = *(const f32x4*)(ropeS + (size_t)row * 32 + i0);
                        const f32x4 x1 = acc[ai][0][m][0], x2 = acc[ai][0][m][1];
                        const f32x4 o1 = x1 * c - x2 * s, o2 = x2 * c + x1 * s;
                        *(u32x4*)((bf16_t*)(ws + WS_KR) + (size_t)row * 64 + lc0) = pack8(o1, o2); }
            } else if (lc0 < 80) {
                const int h0 = lc0 - 64;
                const f32x4 b0 = *(const f32x4*)(bfp + h0), b1 = *(const f32x4*)(bfp + h0 + 4);
#pragma unroll
                for (int ai = 0; ai < 2; ++ai)
#pragma unroll
                    for (int m = 0; m < 4; ++m) { const int row = row0 + ai * HALF + m * 16;
                        f32x4 v0 = acc[ai][0][m][0] + b0, v1 = acc[ai][0][m][1] + b1;
#pragma unroll
                        for (int e = 0; e < 4; ++e) { v0[e] = fminf(v0[e], 0.f) - __logf(1.0f + __expf(-fabsf(v0[e]))); v1[e] = fminf(v1[e], 0.f) - __logf(1.0f + __expf(-fabsf(v1[e]))); }
                        float* lp = (float*)(ws + WS_LOGF) + (size_t)row * 16 + h0;
                        *(f32x4*)lp = v0; *(f32x4*)(lp + 4) = v1; }
            }
            return;
        }
        size_t off; int ldc, colt; float sc = 1.f; int mode = 0;
        if constexpr (I8) {
            if (pn < 6)       { off = WS_ACQ;  ldc = 1536; colt = pn * 256; mode = 2; }
            else if (pn < 14) { off = WS_BQ;   ldc = 2048; colt = (pn - 6) * 256; sc = QS_B; }
            else if (pn < 15) { off = WS_BK;   ldc = 256;  colt = 0; }
            else if (pn < 23) { off = WS_CQ;   ldc = 2048; colt = (pn - 15) * 256; sc = QS_C; }
            else if (pn < 31) { off = WS_CK;   ldc = 2048; colt = (pn - 23) * 256; }
            else if (pn < 39) { off = WS_BZ;   ldc = 2048; colt = (pn - 31) * 256; }
            else if (pn < 47) { off = WS_AZ;   ldc = 2048; colt = (pn - 39) * 256; }
            else if (pn < 55) { off = WS_CZ;   ldc = 2048; colt = (pn - 47) * 256; }
            else              { off = WS_GATES; ldc = 12288; colt = (pn - 55) * 256; mode = 1; }
        } else {
            if (pn < 2)       { off = WS_ACKV; ldc = 512;  colt = pn * 256; mode = 3; }
            else if (pn < 3)  { off = WS_BV;   ldc = 256;  colt = 0; }
            else              { off = WS_CV;   ldc = 2048; colt = (pn - 3) * 256; }
        }
        bf16_t* base = (bf16_t*)(ws + off);
        const int col0 = colt + lc0;
        float sav[2][4];
#pragma unroll
        for (int ai = 0; ai < 2; ++ai)
#pragma unroll
            for (int m = 0; m < 4; ++m) { sav[ai][m] = 1.f; if constexpr (I8) sav[ai][m] = SA[row0 + ai * HALF + m * 16]; }
        asm volatile("" ::: "memory");
#pragma unroll
        for (int ai = 0; ai < 2; ++ai)
#pragma unroll
            for (int m = 0; m < 4; ++m) { const int row = row0 + ai * HALF + m * 16; bf16_t* rowp = base + (size_t)row * ldc + col0; const float sa = sav[ai][m];
                float ss = 0.f;
#pragma unroll
                for (int bj = 0; bj < 2; ++bj) { f32x4 v0 = DEQ(ai, bj, m, 0, sa), v1 = DEQ(ai, bj, m, 1, sa);
                    if (mode >= 2) ss += (v0[0] * v0[0] + v0[1] * v0[1]) + (v0[2] * v0[2] + v0[3] * v0[3]) + (v1[0] * v1[0] + v1[1] * v1[1]) + (v1[2] * v1[2] + v1[3] * v1[3]);
                    if (mode == 1) {
#pragma unroll
                        for (int e = 0; e < 4; ++e) { v0[e] = sigmoidf_(v0[e]); v1[e] = sigmoidf_(v1[e]); } }
                    else { v0 = v0 * sc; v1 = v1 * sc; }
                    if (mode == 1) *((u32x4*)(ws + WS_GATES) + gate_slot(u.pm * 48 + (pn - 55), ai, m, bj, wr * 4 + wc, fq * 16 + fr)) = pack8(v0, v1);
                    else *(u32x4*)(rowp + bj * HALF) = pack8(v0, v1); }
                if (mode >= 2) { ss += __shfl_xor(ss, 16); ss += __shfl_xor(ss, 32);
                    if (fq == 0) atomicAdd((mode == 2 ? rsq : rskv) + row, (unsigned long long)(ss * 4294967296.0f)); } }
#undef DEQ
    }
};

struct EpiQA {
    static constexpr bool PERM = true, AFTER_DRAIN = false, ASM_MMA = false, MIDK = false;
    unsigned char* ws; int layer;
    __device__ __forceinline__ void operator()(const f32x4 (&acc)[2][2][4][2], const Unit& u, int wr, int wc, int fr_in, int fq_in) const {
        int fr = fr_in, fq = fq_in; asm volatile("" : "+v"(fr), "+v"(fq));
        bf16_t* O = (bf16_t*)(ws + WS_QA); const unsigned long long* rsq = (const unsigned long long*)(ws + WS_RS) + (size_t)layer * 2 * M_ROWS;
        const float* ropeC = (const float*)(ws + WS_ROPEC); const float* ropeS = (const float*)(ws + WS_ROPES); constexpr float qs = QS_A;
        const int row0 = u.pm * BM + wr * 64 + fr;
        const int colb = u.pn * BM + wc * 32 + 8 * fq;
        unsigned long long rq[2][4];
#pragma unroll
        for (int ai = 0; ai < 2; ++ai)
#pragma unroll
            for (int m = 0; m < 4; ++m) rq[ai][m] = rsq[row0 + ai * HALF + m * 16];
        const int cm0 = colb % 192, cm1 = (colb + HALF) % 192;
#pragma unroll
        for (int q = 0; q < 4; ++q) {
            f32x4 cv[2][2], sv[2][2];
#pragma unroll
            for (int mm = 0; mm < 2; ++mm) { const int row = row0 + (q >> 1) * HALF + ((q & 1) * 2 + mm) * 16;
                if (cm0 >= 128) { const int i0 = ((cm0 - 128) >> 3) * 4; cv[mm][0] = *(const f32x4*)(ropeC + (size_t)row * 32 + i0); sv[mm][0] = *(const f32x4*)(ropeS + (size_t)row * 32 + i0); }
                if (cm1 >= 128) { const int i0 = ((cm1 - 128) >> 3) * 4; cv[mm][1] = *(const f32x4*)(ropeC + (size_t)row * 32 + i0); sv[mm][1] = *(const f32x4*)(ropeS + (size_t)row * 32 + i0); } }
            asm volatile("" ::: "memory");
#pragma unroll
            for (int mm = 0; mm < 2; ++mm) { const int ai = q >> 1, m = (q & 1) * 2 + mm; const int row = row0 + ai * HALF + m * 16;
                const float rs = __builtin_amdgcn_rsqf((float)rq[ai][m] * (2.3283064365386963e-10f / 1536.0f) + 1e-6f) * qs;
#pragma unroll
                for (int bj = 0; bj < 2; ++bj) { const int col = colb + bj * HALF; const int cm = bj ? cm1 : cm0;
                    f32x4 v0 = acc[ai][bj][m][0] * rs, v1 = acc[ai][bj][m][1] * rs;
                    if (cm >= 128) { const f32x4 c = cv[mm][bj], s = sv[mm][bj]; const f32x4 o1 = v0 * c - v1 * s, o2 = v1 * c + v0 * s; v0 = o1; v1 = o2; }
                    *(u32x4*)(O + (size_t)row * 3072 + col) = pack8(v0, v1); } }
        }
    }
};

struct EpiKV {
    static constexpr bool PERM = true, AFTER_DRAIN = false, ASM_MMA = false, MIDK = false;
    unsigned char* ws; int layer;
    __device__ __forceinline__ void operator()(const f32x4 (&acc)[2][2][4][2], const Unit& u, int wr, int wc, int fr_in, int fq_in) const {
        int fr = fr_in, fq = fq_in; asm volatile("" : "+v"(fr), "+v"(fq));
        const unsigned long long* rskv = (const unsigned long long*)(ws + WS_RS) + (size_t)layer * 2 * M_ROWS + M_ROWS;
        const int row0 = u.pm * BM + wr * 64 + fr;
        bf16_t* base = (bf16_t*)(ws + (u.pn < 8 ? WS_KA : WS_VA));
        const int col0 = (u.pn & 7) * BM + wc * 32 + 8 * fq;
        unsigned long long rq[2][4];
#pragma unroll
        for (int ai = 0; ai < 2; ++ai)
#pragma unroll
            for (int m = 0; m < 4; ++m) rq[ai][m] = rskv[row0 + ai * HALF + m * 16];
        asm volatile("" ::: "memory");
#pragma unroll
        for (int ai = 0; ai < 2; ++ai)
#pragma unroll
            for (int m = 0; m < 4; ++m) { const int row = row0 + ai * HALF + m * 16;
                const float rs = __builtin_amdgcn_rsqf((float)rq[ai][m] * (2.3283064365386963e-10f / 512.0f) + 1e-6f);
#pragma unroll
                for (int bj = 0; bj < 2; ++bj)
                    *(u32x4*)(base + (size_t)row * 2048 + col0 + bj * HALF) = pack8(acc[ai][bj][m][0] * rs, acc[ai][bj][m][1] * rs); }
    }
};

template <int GVAR = 0> struct EpiGateT {
    static constexpr bool PERM = true, AFTER_DRAIN = false, ASM_MMA = false, MIDK = false;
    unsigned char* ws; size_t yoff;
    __device__ __forceinline__ void operator()(const f32x4 (&acc)[2][2][4][2], const Unit& u, int wr, int wc, int fr_in, int fq_in) const {
        int fr = fr_in, fq = fq_in; asm volatile("" : "+v"(fr), "+v"(fq));
        const bf16_t* gates = (const bf16_t*)(ws + WS_GATES); bf16_t* Y = (bf16_t*)(ws + yoff);
        const int br = u.pm >> 6, pm = u.pm & 63, pn = u.pn & 15;
        const int row0 = pm * BM + wr * 64 + fr, col0 = pn * BM + wc * 32 + 8 * fq;
#pragma unroll
        for (int q = 0; q < 4; ++q) {
            u32x4 gv[2][2], yv[2][2];
#pragma unroll
            for (int mm = 0; mm < 2; ++mm)
#pragma unroll
                for (int bj = 0; bj < 2; ++bj) { const int row = row0 + (q >> 1) * HALF + ((q & 1) * 2 + mm) * 16;
                    if constexpr (GVAR & 2) gv[mm][bj] = (u32x4){0x3f003f00u, 0x3f003f00u, 0x3f003f00u, 0x3f003f00u}; else gv[mm][bj] = *(const u32x4*)(gates + (size_t)row * 12288 + br * 4096 + col0 + bj * HALF);
                    if (!(GVAR & 1) && br > 0) yv[mm][bj] = *(const u32x4*)(Y + (size_t)row * 4096 + col0 + bj * HALF); }
            asm volatile("" ::: "memory");
#pragma unroll
            for (int mm = 0; mm < 2; ++mm) { const int ai = q >> 1, m = (q & 1) * 2 + mm; const int row = row0 + ai * HALF + m * 16;
#pragma unroll
                for (int bj = 0; bj < 2; ++bj) { const int col = col0 + bj * HALF; const u32x4 g = gv[mm][bj];
                    f32x4 v0 = acc[ai][bj][m][0], v1 = acc[ai][bj][m][1];
                    v0[0] *= bf_lo(g.x); v0[1] *= bf_hi(g.x); v0[2] *= bf_lo(g.y); v0[3] *= bf_hi(g.y);
                    v1[0] *= bf_lo(g.z); v1[1] *= bf_hi(g.z); v1[2] *= bf_lo(g.w); v1[3] *= bf_hi(g.w);
                    if (!(GVAR & 1) && br > 0) { const u32x4 y = yv[mm][bj]; v0[0] += bf_lo(y.x); v0[1] += bf_hi(y.x); v0[2] += bf_lo(y.y); v0[3] += bf_hi(y.y); v1[0] += bf_lo(y.z); v1[1] += bf_hi(y.z); v1[2] += bf_lo(y.w); v1[3] += bf_hi(y.w); }
                    *(u32x4*)(Y + (size_t)row * 4096 + col) = pack8(v0, v1); } }
            asm volatile("" ::: "memory");
        }
    }
};
typedef EpiGateT<0> EpiGate;
struct GateOrder {
    StaticOrder S;
    __device__ __forceinline__ bool next(int i, Unit& u) const { const int t = i / 3, br = i - 3 * t; Unit v; if (!S.next(t, v)) return false; u.pm = br * 64 + v.pm; u.pn = br * 16 + v.pn; return true; }
    __device__ __forceinline__ void a_ready(const Unit&) const {}
    __device__ __forceinline__ void done(const Unit&) const {}
};

struct EpiGate3 {
    static constexpr bool PERM = true, AFTER_DRAIN = false, ASM_MMA = false, MIDK = true;
    static constexpr int MID0 = 32, MID1 = 64;
    unsigned char* ws; size_t yoff;
    __device__ __forceinline__ void mid(f32x4 (&acc)[2][2][4][2], const Unit& u, int wr, int wc, int fr_in, int fq_in, int step) const {
        int fr = fr_in, fq = fq_in; asm volatile("" : "+v"(fr), "+v"(fq));
        const u32x4* gbase = (const u32x4*)(ws + WS_GATES); const int tnum = u.pm * 48 + step * 16 + u.pn, tden = tnum + 16, wv = wr * 4 + wc, ln = fq * 16 + fr;
        u32x4 gn[2][2][2], gd[2][2][2];
#define G3_LOAD(q_, s_) do { _Pragma("unroll") for (int mm = 0; mm < 2; ++mm) _Pragma("unroll") for (int bj = 0; bj < 2; ++bj) { \
            gn[s_][mm][bj] = gbase[gate_slot(tnum, (q_) >> 1, ((q_) & 1) * 2 + mm, bj, wv, ln)]; gd[s_][mm][bj] = gbase[gate_slot(tden, (q_) >> 1, ((q_) & 1) * 2 + mm, bj, wv, ln)]; } } while (0)
        G3_LOAD(0, 0);
#pragma unroll
        for (int q = 0; q < 4; ++q) {
            if (q < 3) G3_LOAD(q + 1, (q + 1) & 1);
            asm volatile("" ::: "memory");
#pragma unroll
            for (int mm = 0; mm < 2; ++mm) { const int ai = q >> 1, m = (q & 1) * 2 + mm;
#pragma unroll
                for (int bj = 0; bj < 2; ++bj) { const u32x4 n = gn[q & 1][mm][bj], d = gd[q & 1][mm][bj]; const unsigned nw[4] = {n.x, n.y, n.z, n.w}, dw[4] = {d.x, d.y, d.z, d.w};
#pragma unroll
                    for (int e = 0; e < 4; ++e) { const float r0 = fmaxf(bf_lo(nw[e]), 1e-20f) * __builtin_amdgcn_rcpf(fmaxf(bf_lo(dw[e]), 1e-20f)), r1 = fmaxf(bf_hi(nw[e]), 1e-20f) * __builtin_amdgcn_rcpf(fmaxf(bf_hi(dw[e]), 1e-20f));
                        acc[ai][bj][m][e >> 1][(e & 1) * 2] *= r0; acc[ai][bj][m][e >> 1][(e & 1) * 2 + 1] *= r1; } } }
        }
#undef G3_LOAD
    }
    __device__ __forceinline__ void operator()(const f32x4 (&acc)[2][2][4][2], const Unit& u, int wr, int wc, int fr_in, int fq_in) const {
        int fr = fr_in, fq = fq_in; asm volatile("" : "+v"(fr), "+v"(fq));
        const u32x4* gbase = (const u32x4*)(ws + WS_GATES); const int tg = u.pm * 48 + 2 * 16 + u.pn, wv = wr * 4 + wc, ln = fq * 16 + fr; bf16_t* Y = (bf16_t*)(ws + yoff);
        const int row0 = u.pm * BM + wr * 64 + fr, col0 = u.pn * BM + wc * 32 + 8 * fq;
        u32x4 gv[4][2][2];
#pragma unroll
        for (int q = 0; q < 4; ++q)
#pragma unroll
            for (int mm = 0; mm < 2; ++mm)
#pragma unroll
                for (int bj = 0; bj < 2; ++bj) gv[q][mm][bj] = gbase[gate_slot(tg, q >> 1, (q & 1) * 2 + mm, bj, wv, ln)];
        asm volatile("" ::: "memory");
#pragma unroll
        for (int q = 0; q < 4; ++q) {
#pragma unroll
            for (int mm = 0; mm < 2; ++mm) { const int ai = q >> 1, m = (q & 1) * 2 + mm; const int row = row0 + ai * HALF + m * 16;
#pragma unroll
                for (int bj = 0; bj < 2; ++bj) { const u32x4 g = gv[q][mm][bj];
                    f32x4 v0 = acc[ai][bj][m][0], v1 = acc[ai][bj][m][1];
                    v0[0] *= fmaxf(bf_lo(g.x), 1e-20f); v0[1] *= fmaxf(bf_hi(g.x), 1e-20f); v0[2] *= fmaxf(bf_lo(g.y), 1e-20f); v0[3] *= fmaxf(bf_hi(g.y), 1e-20f);
                    v1[0] *= fmaxf(bf_lo(g.z), 1e-20f); v1[1] *= fmaxf(bf_hi(g.z), 1e-20f); v1[2] *= fmaxf(bf_lo(g.w), 1e-20f); v1[3] *= fmaxf(bf_hi(g.w), 1e-20f);
                    *(u32x4*)(Y + ((size_t)((u.pm * 64 + u.pn * 4 + bj * 2 + (wc >> 1)) * 256) + (row - u.pm * BM)) * 64 + (wc & 1) * 32 + 8 * fq) = pack8(v0, v1); } }
        }
    }
};

struct EpiZ16 {
    static constexpr bool PERM = true, AFTER_DRAIN = false, ASM_MMA = false, MIDK = false;
    bf16_t* O; int ldc;
    __device__ __forceinline__ void operator()(const f32x4 (&acc)[2][2][4][2], const Unit& u, int wr, int wc, int fr_in, int fq_in) const {
        int fr = fr_in, fq = fq_in; asm volatile("" : "+v"(fr), "+v"(fq));
        const int row0 = u.pm * BM + wr * 64 + fr, col0 = u.pn * BM + wc * 32 + 8 * fq;
#pragma unroll
        for (int ai = 0; ai < 2; ++ai)
#pragma unroll
            for (int m = 0; m < 4; ++m) { bf16_t* rowp = O + (size_t)(u.pm * 16 + u.pn) * 65536 + (size_t)(wr * 64 + fr + ai * HALF + m * 16) * 256 + wc * 32 + 8 * fq;
#pragma unroll
                for (int bj = 0; bj < 2; ++bj) *(u32x4*)(rowp + bj * HALF) = pack8(acc[ai][bj][m][0], acc[ai][bj][m][1]); }
    }
};

struct EpiNull {
    static constexpr bool PERM = true, AFTER_DRAIN = false, ASM_MMA = false, MIDK = false;
    float* sink;
    __device__ __forceinline__ void operator()(const f32x4 (&acc)[2][2][4][2], const Unit& u, int wr, int wc, int fr_in, int fq_in) const {
        int fr = fr_in, fq = fq_in; asm volatile("" : "+v"(fr), "+v"(fq));
        float s = 0.f;
#pragma unroll
        for (int ai = 0; ai < 2; ++ai)
#pragma unroll
            for (int bj = 0; bj < 2; ++bj)
#pragma unroll
                for (int m = 0; m < 4; ++m)
#pragma unroll
                    for (int n = 0; n < 2; ++n) s += acc[ai][bj][m][n][0] + acc[ai][bj][m][n][1] + acc[ai][bj][m][n][2] + acc[ai][bj][m][n][3];
        if (s == 1.2345678e33f) sink[0] = s;
    }
};
struct FixedOrder {
    int n, pm0, pn0, dpm, dpn;
    __device__ __forceinline__ bool next(int i, Unit& u) const { if (i >= n) return false; u.pm = pm0 + i * dpm; u.pn = pn0 + i * dpn; return true; }
    __device__ __forceinline__ void a_ready(const Unit&) const {}
    __device__ __forceinline__ void done(const Unit&) const {}
};
template <class Epi, class Sched, bool ALIGN_EPI = false, bool SP2 = false, bool FP8 = false>
__device__ __forceinline__ void gemm_phase(PG8_LAS unsigned char* lds, const Gemm g, const Sched& S, const Epi& E) {
    int tid_l = threadIdx.x; asm volatile("" : "+v"(tid_l));
    const int tid = tid_l, wid = __builtin_amdgcn_readfirstlane(tid >> 6), lane = tid & 63, wr = wid >> 2, wc = wid & 3, fr = lane & 15, fq = lane >> 4;
    const int K = g.K, nt = K / BK;
    unsigned voffA[2], voffB[2];
#pragma unroll
    for (int i = 0; i < 2; ++i) { int R, C; stage_rc(tid * 16 + i * 8192, R, C); const int Rb = Epi::PERM ? ((R & ~31) + perm32(R & 31)) : R;
        voffA[i] = (unsigned)(R * (g.aktm ? BK : K) + C) * 2u; voffB[i] = (unsigned)(Rb * K + C) * 2u; }
    const size_t kstep = (size_t)(BK * 2);
    const size_t hstep = (size_t)HALF * K * 2;
    const size_t tstep = 2 * hstep;
    const size_t kstepA = g.aktm ? (size_t)(BM * BK * 2) : kstep, hstepA = g.aktm ? (size_t)(HALF * BK * 2) : hstep, tstepA = g.aktm ? (size_t)nt * (BM * BK * 2) : tstep;
    const unsigned ldsw = (unsigned)wid * 1024u;
    const int aoff = lds_byte(wr * 64 + fr, fq * 8), boff = lds_byte(wc * 32 + fr, fq * 8);
#define PG8_SA(b, h) (((b) * 2 + (h)) * HTB)
#define PG8_SB(b, h) ((4 + (b) * 2 + (h)) * HTB)
#define PG8_STAGE(bufoff, gbase, voff) do { _Pragma("unroll") for (int _i = 0; _i < 2; ++_i) \
        __builtin_amdgcn_global_load_lds((const unsigned*)((const char*)(gbase) + (voff)[_i]), (PG8_LAS unsigned*)(lds + (bufoff) + ldsw + _i * 8192), 16, 0, 0); } while (0)
typedef int pg8_v8i __attribute__((ext_vector_type(8))); typedef int pg8_v2i __attribute__((ext_vector_type(2))); typedef int pg8_v4i __attribute__((ext_vector_type(4)));
#define PG8_CAT(x, y) __builtin_shufflevector(__builtin_bit_cast(pg8_v4i, x), __builtin_bit_cast(pg8_v4i, y), 0, 1, 2, 3, 4, 5, 6, 7)
#define PG8_LDA(dst, b, h) do { _Pragma("unroll") for (int m = 0; m < 4; ++m) _Pragma("unroll") for (int k = 0; k < 2; ++k) dst[m][k] = *(const PG8_LAS bf16x8*)(lds + PG8_SA(b, h) + aoff + m * 2048 + k * 1024); } while (0)
#define PG8_LDB(dst, b, h) do { _Pragma("unroll") for (int n = 0; n < 2; ++n) _Pragma("unroll") for (int k = 0; k < 2; ++k) dst[n][k] = *(const PG8_LAS bf16x8*)(lds + PG8_SB(b, h) + boff + n * 2048 + k * 1024); } while (0)
#define PG8_MMA(ai, bj, At, Bt) do { __builtin_amdgcn_s_setprio(1); \
        if constexpr (FP8) { _Pragma("unroll") for (int m = 0; m < 4; ++m) _Pragma("unroll") for (int n = 0; n < 2; ++n) _Pragma("unroll") for (int k = 0; k < 2; ++k) \
            acc[ai][bj][m][n] = __builtin_bit_cast(f32x4, __builtin_amdgcn_mfma_i32_16x16x64_i8(__builtin_bit_cast(pg8_v4i, Bt[n][k]), __builtin_bit_cast(pg8_v4i, At[m][k]), __builtin_bit_cast(pg8_v4i, acc[ai][bj][m][n]), 0, 0, 0)); } \
        else { _Pragma("unroll") for (int m = 0; m < 4; ++m) _Pragma("unroll") for (int n = 0; n < 2; ++n) _Pragma("unroll") for (int k = 0; k < 2; ++k) \
            acc[ai][bj][m][n] = __builtin_amdgcn_mfma_f32_16x16x32_bf16(Bt[n][k], At[m][k], acc[ai][bj][m][n], 0, 0, 0); } \
        __builtin_amdgcn_s_setprio(0); } while (0)
#define PG8_WAIT_V(n) asm volatile("s_waitcnt vmcnt(" #n ")" ::: "memory")
#define PG8_WAIT_L(n) asm volatile("s_waitcnt lgkmcnt(" #n ")" ::: "memory")
#define PG8_BAR __builtin_amdgcn_s_barrier()
#define PG8_SCHED __builtin_amdgcn_sched_barrier(0)
    Unit cur, nxt; int ui = 0;
    if (!S.next(0, cur)) return;
    f32x4 acc[2][2][4][2];
#pragma unroll
    for (int a = 0; a < 2; ++a)
#pragma unroll
        for (int b = 0; b < 2; ++b)
#pragma unroll
            for (int m = 0; m < 4; ++m)
#pragma unroll
                for (int n = 0; n < 2; ++n) acc[a][b][m][n] = (f32x4){0.f, 0.f, 0.f, 0.f};
    bf16x8 At[4][2], B0[2][2], B1[2][2];
    const char* cA = (const char*)g.A + (size_t)cur.pm * tstepA; const char* cB = (const char*)g.Bt + (size_t)cur.pn * tstep;
    S.a_ready(cur);
    if constexpr (SP2) {
        PG8_STAGE(PG8_SB(0, 0), cB, voffB); PG8_STAGE(PG8_SB(0, 1), cB + hstep, voffB); PG8_STAGE(PG8_SA(0, 0), cA, voffA); PG8_STAGE(PG8_SA(0, 1), cA + hstepA, voffA);
        if (wr == 1) PG8_BAR;
        PG8_WAIT_V(2); PG8_BAR;
        PG8_STAGE(PG8_SB(1, 0), cB + kstep, voffB); PG8_STAGE(PG8_SA(1, 0), cA + kstepA, voffA); PG8_STAGE(PG8_SB(1, 1), cB + hstep + kstep, voffB);
        PG8_WAIT_V(6); PG8_BAR;
    } else {
        PG8_STAGE(PG8_SB(0, 0), cB, voffB); PG8_STAGE(PG8_SA(0, 0), cA, voffA); PG8_STAGE(PG8_SB(0, 1), cB + hstep, voffB); PG8_STAGE(PG8_SA(0, 1), cA + hstepA, voffA);
        if (wr == 1) PG8_BAR;
        PG8_WAIT_V(4); PG8_BAR;
        PG8_STAGE(PG8_SB(1, 0), cB + kstep, voffB); PG8_STAGE(PG8_SA(1, 0), cA + kstepA, voffA); PG8_STAGE(PG8_SB(1, 1), cB + hstep + kstep, voffB);
        PG8_WAIT_V(6); PG8_BAR;
    }
    for (;;) {
        const bool has_next = S.next(ui + 1, nxt);
        const char* nA = has_next ? (const char*)g.A + (size_t)nxt.pm * tstepA : cA; const char* nB = has_next ? (const char*)g.Bt + (size_t)nxt.pn * tstep : cB;
        for (int t = 0; t < nt; t += 2) {
            const bool last = (t == nt - 2);
            const char* a1 = cA + (size_t)(t + 1) * kstepA;
            const char* a2 = last ? nA : cA + (size_t)(t + 2) * kstepA; const char* b2 = last ? nB : cB + (size_t)(t + 2) * kstep;
            const char* a3 = a2 + kstepA; const char* b3 = b2 + kstep;
            if (last && has_next) S.a_ready(nxt);
            if constexpr (Epi::MIDK) {
                if (t == Epi::MID0 || t == Epi::MID1) { if (wr == 0) PG8_BAR; E.mid(acc, cur, wr, wc, fr, fq, t == Epi::MID0 ? 0 : 1); if (wr == 1) PG8_BAR; }
            }
            if constexpr (SP2) {
            PG8_LDB(B0, 0, 0); PG8_LDB(B1, 0, 1); PG8_SCHED; PG8_LDA(At, 0, 0); PG8_STAGE(PG8_SA(1, 1), a1 + hstepA, voffA);
            PG8_WAIT_V(8); PG8_WAIT_L(0); PG8_BAR; PG8_MMA(0, 0, At, B0); PG8_MMA(0, 1, At, B1); PG8_BAR; PG8_SCHED;
            PG8_LDA(At, 0, 1); PG8_STAGE(PG8_SB(0, 0), b2, voffB); PG8_STAGE(PG8_SB(0, 1), b2 + hstep, voffB); PG8_STAGE(PG8_SA(0, 0), a2, voffA);
            PG8_WAIT_V(8); PG8_WAIT_L(0); PG8_BAR; PG8_MMA(1, 0, At, B0); PG8_MMA(1, 1, At, B1); PG8_BAR; PG8_SCHED;
            PG8_LDB(B0, 1, 0); PG8_LDB(B1, 1, 1); PG8_SCHED; PG8_LDA(At, 1, 0); PG8_STAGE(PG8_SA(0, 1), a2 + hstepA, voffA);
            PG8_WAIT_V(8); PG8_WAIT_L(0); PG8_BAR; PG8_MMA(0, 0, At, B0); PG8_MMA(0, 1, At, B1); PG8_BAR; PG8_SCHED;
            PG8_LDA(At, 1, 1); PG8_STAGE(PG8_SB(1, 0), b3, voffB); PG8_STAGE(PG8_SB(1, 1), b3 + hstep, voffB); PG8_STAGE(PG8_SA(1, 0), a3, voffA);
            PG8_WAIT_V(8); PG8_WAIT_L(0); PG8_BAR; PG8_MMA(1, 0, At, B0); PG8_MMA(1, 1, At, B1); PG8_BAR; PG8_SCHED;
            } else {
            PG8_LDB(B0, 0, 0); PG8_SCHED; PG8_LDA(At, 0, 0); PG8_STAGE(PG8_SA(1, 1), a1 + hstepA, voffA);
            PG8_WAIT_L(8); PG8_BAR; PG8_WAIT_L(0); PG8_MMA(0, 0, At, B0); PG8_BAR; PG8_SCHED;
            PG8_LDB(B1, 0, 1); PG8_STAGE(PG8_SB(0, 0), b2, voffB);
            PG8_BAR; PG8_WAIT_L(0); PG8_MMA(0, 1, At, B1); PG8_BAR;
            PG8_LDA(At, 0, 1); PG8_STAGE(PG8_SA(0, 0), a2, voffA);
            PG8_BAR; PG8_WAIT_L(0); PG8_MMA(1, 0, At, B0); PG8_BAR; PG8_SCHED;
            PG8_STAGE(PG8_SB(0, 1), b2 + hstep, voffB);
            PG8_WAIT_V(6); PG8_BAR; PG8_MMA(1, 1, At, B1); PG8_BAR;
            PG8_LDB(B0, 1, 0); PG8_SCHED; PG8_LDA(At, 1, 0); PG8_STAGE(PG8_SA(0, 1), a2 + hstepA, voffA);
            PG8_WAIT_L(8); PG8_BAR; PG8_WAIT_L(0); PG8_MMA(0, 0, At, B0); PG8_BAR; PG8_SCHED;
            PG8_LDB(B1, 1, 1); PG8_STAGE(PG8_SB(1, 0), b3, voffB);
            PG8_BAR; PG8_WAIT_L(0); PG8_MMA(0, 1, At, B1); PG8_BAR;
            PG8_LDA(At, 1, 1); PG8_STAGE(PG8_SA(1, 0), a3, voffA);
            PG8_BAR; PG8_WAIT_L(0); PG8_MMA(1, 0, At, B0); PG8_BAR; PG8_SCHED;
            PG8_STAGE(PG8_SB(1, 1), b3 + hstep, voffB);
            PG8_WAIT_V(6); PG8_BAR; PG8_MMA(1, 1, At, B1); PG8_BAR;
            }
        }
        if constexpr (ALIGN_EPI) { if (wr == 0) PG8_BAR; }
        if constexpr (!Epi::AFTER_DRAIN) { E(acc, cur, wr, wc, fr, fq); S.done(cur); }
        if (!has_next) break;
#pragma unroll
        for (int a = 0; a < 2; ++a)
#pragma unroll
            for (int b = 0; b < 2; ++b)
#pragma unroll
                for (int m = 0; m < 4; ++m)
#pragma unroll
                    for (int n = 0; n < 2; ++n) acc[a][b][m][n] = (f32x4){0.f, 0.f, 0.f, 0.f};
        cur = nxt; cA = nA; cB = nB; ++ui;
        if constexpr (ALIGN_EPI) { if (wr == 1) PG8_BAR; }
    }
    PG8_WAIT_V(0);
    if constexpr (!ALIGN_EPI) { if (wr == 0) PG8_BAR; }
    PG8_BAR;
    if constexpr (Epi::AFTER_DRAIN) { E.fused(acc, cur, wr, wc, fr, fq, lds, wid, lane); S.done(cur); }
#undef PG8_SA
#undef PG8_SB
#undef PG8_STAGE
#undef PG8_LDA
#undef PG8_LDB
#undef PG8_MMA
#undef PG8_CAT
#undef PG8_WAIT_V
#undef PG8_WAIT_L
#undef PG8_BAR
#undef PG8_SCHED
}
}
#define GAS __attribute__((address_space(1)))
#define LAS __attribute__((address_space(3)))
typedef unsigned short bf16;
typedef unsigned v4u __attribute__((ext_vector_type(4)));
typedef float f32x4 __attribute__((ext_vector_type(4)));
typedef short bf16x8 __attribute__((ext_vector_type(8)));
typedef GAS unsigned gu32;
typedef GAS unsigned long long gu64;
#define RLX_AGENT __ATOMIC_RELAXED, __HIP_MEMORY_SCOPE_AGENT
#define LDS_WAIT() asm volatile("s_waitcnt lgkmcnt(0)" ::: "memory")
#define VM_WAIT() asm volatile("s_waitcnt vmcnt(0)" ::: "memory")
__device__ __forceinline__ unsigned long long rt() { return __builtin_amdgcn_s_memrealtime(); }
__device__ __forceinline__ unsigned f2bf(float f) { unsigned u = __builtin_bit_cast(unsigned, f); return (u + 0x7fffu + ((u >> 16) & 1u)) >> 16; }
__device__ __forceinline__ unsigned pk2(float lo, float hi) { return f2bf(lo) | (f2bf(hi) << 16); }
#define XB_TMO      128
#define XB_XCNT(j)  (256  + 64 * (j))
#define XB_XSUB(j)  (1280 + 64 * (j))
#define XB_XGEN(j)  (2304 + 64 * (j))
#define XB_TOP      3328
#define XB_TOPGEN   3392
#define XCD_BAR_WORDS 3456
#define XB_SPIN_CAP (1u << 18)

__device__ __forceinline__ unsigned xb_ld(unsigned* p)              { return __hip_atomic_load(p, __ATOMIC_RELAXED, __HIP_MEMORY_SCOPE_AGENT); }
__device__ __forceinline__ unsigned xb_add(unsigned* p, unsigned v) { return __hip_atomic_fetch_add(p, v, __ATOMIC_RELAXED, __HIP_MEMORY_SCOPE_AGENT); }
__device__ __forceinline__ unsigned xb_xcc_id() { return (unsigned)__builtin_amdgcn_s_getreg((3 << 11) | 20) & 0xFu; }
#define XB_SPIN(cond, bar) do { unsigned _sp = 0; while (cond) { __builtin_amdgcn_s_sleep(1); \
    if ((++_sp & 255u) == 0u) { if (xb_ld(&(bar)[XB_TMO])) break; if (_sp > XB_SPIN_CAP) { atomicAdd(&(bar)[XB_TMO], 1u); break; } } } } while (0)

struct XcdBarrier {
    unsigned* bar; unsigned x;
    volatile LAS unsigned* st;
};

__device__ __forceinline__ XcdBarrier xcd_barrier_post(unsigned* bar, volatile LAS unsigned* st) {
    XcdBarrier b; b.bar = bar; b.x = xb_xcc_id(); b.st = st;
    if (threadIdx.x == 0) (void)xb_add(&bar[XB_XCNT(b.x)], 1u);
    return b;
}
__device__ __forceinline__ void xcd_barrier_complete(unsigned* bar, unsigned x, unsigned& nloc, unsigned& nx) {
    const unsigned G = gridDim.x * gridDim.y * gridDim.z;
    unsigned sum, cnt, mine, sp = 0u;
    for (;;) {
        sum = 0u; cnt = 0u; mine = 0u;
#pragma unroll
        for (unsigned j = 0; j < 16; ++j) { const unsigned c = xb_ld(&bar[XB_XCNT(j)]); sum += c; cnt += (c > 0u) ? 1u : 0u; mine = (j == x) ? c : mine; }
        if (sum == G) break;
        __builtin_amdgcn_s_sleep(1);
        if ((++sp & 255u) == 0u) { if (xb_ld(&bar[XB_TMO])) break; if (sp > XB_SPIN_CAP) { atomicAdd(&bar[XB_TMO], 1u); break; } }
    }
    nloc = mine > 0u ? mine : 1u; nx = cnt > 0u ? cnt : 1u;
}

__device__ __forceinline__ void xcd_barrier(const XcdBarrier& b) {
    asm volatile("s_waitcnt vmcnt(0)" ::: "memory");
    __syncthreads();
    if (threadIdx.x == 0) {
        unsigned* bar = b.bar;
        __builtin_amdgcn_s_waitcnt(0);
        unsigned nloc = b.st[0], nx = b.st[1];
        if (nloc == 0u) { xcd_barrier_complete(bar, b.x, nloc, nx); b.st[0] = nloc; b.st[1] = nx; }
        const unsigned old = xb_add(&bar[XB_XSUB(b.x)], 1u);
        const unsigned gen = old / nloc;
        if (old + 1u == (gen + 1u) * nloc) {
            __builtin_amdgcn_fence(__ATOMIC_RELEASE, "agent");
            asm volatile("s_waitcnt vmcnt(0)" ::: "memory");
            const unsigned og = xb_add(&bar[XB_TOP], 1u);
            const unsigned tg = og / nx;
            if (og + 1u == (tg + 1u) * nx) xb_add(&bar[XB_TOPGEN], 1u);
            else XB_SPIN(xb_ld(&bar[XB_TOPGEN]) == tg, bar);
            __builtin_amdgcn_fence(__ATOMIC_ACQUIRE, "agent");
            xb_add(&bar[XB_XGEN(b.x)], 1u);
            asm volatile("s_waitcnt vmcnt(0)" ::: "memory");
        } else {
            XB_SPIN(xb_ld(&bar[XB_XGEN(b.x)]) == gen, bar);
            __builtin_amdgcn_fence(__ATOMIC_ACQUIRE, "agent");
            asm volatile("s_waitcnt vmcnt(0)" ::: "memory");
        }
    }
    __syncthreads();
}
namespace att {
typedef unsigned short bf16_t;
typedef short bf16x8 __attribute__((ext_vector_type(8)));
typedef short s16x4 __attribute__((ext_vector_type(4)));
typedef float f32x16 __attribute__((ext_vector_type(16)));
typedef float f32x4 __attribute__((ext_vector_type(4)));
typedef unsigned u32x4 __attribute__((ext_vector_type(4)));
#define ATT_LAS __attribute__((address_space(3)))
#define ATT_SBAR() __builtin_amdgcn_sched_barrier(0)
#ifndef ATT_SPLIT
#define ATT_SPLIT 4
#endif
constexpr int SEQ = 2048, QB = 256, KVBLK = 64, OPITCH = 6144  ;
constexpr int L_K = 0, L_KSZ = 25600, L_V = 2 * L_KSZ, L_VSZ = 16384, L_WS = L_V + 2 * L_VSZ, L_TAB = L_WS + 8 * 256, L_QR = L_TAB + 8192  , L_END = L_QR + 8 * 4096;
constexpr float LOG2E = 1.4426950408889634f;

struct Args {
    const bf16_t* Q; const bf16_t* K; const bf16_t* KR; const bf16_t* V; const bf16_t* Z; bf16_t* O;
    const float* CB;
    const float* relt;
    const float* sinks;
};
template <int KIND> struct Cfg;
template <> struct Cfg<0> { static constexpr int DK = 192, DV = 128, QP = 3072, KP = 2048, VP = 2048, NH = 16, G = 1; };
template <> struct Cfg<1> { static constexpr int DK = 64,  DV = 64,  QP = 2048, KP = 256,  VP = 256,  NH = 32, G = 8; };
template <> struct Cfg<2> { static constexpr int DK = 128, DV = 128, QP = 2048, KP = 2048, VP = 2048, NH = 16, G = 1; };

__device__ __forceinline__ int crow(int r, int hi) { return (r & 3) + 8 * (r >> 2) + 4 * hi; }
typedef float att_f32x2 __attribute__((ext_vector_type(2))); typedef __bf16 att_bf16x2 __attribute__((ext_vector_type(2)));
__device__ __forceinline__ unsigned cvtpk(float lo, float hi) { const att_f32x2 v = {lo, hi}; const att_bf16x2 b = __builtin_convertvector(v, att_bf16x2); return __builtin_bit_cast(unsigned, b); }
template <int DV> __device__ __forceinline__ int v_st(int k, int c) { constexpr int NS = DV / 32; const int kk = (k & ~0xC) | ((k & 4) << 1) | ((k & 8) >> 1); return ((kk >> 3) * NS + (c >> 5)) * 512 + ((kk & 7) * 32 + (c & 31)) * 2; }
__device__ __forceinline__ int v_rd_base(int lane) { return ((lane & 3) << 3) | (((lane >> 2) & 3) << 6) | (((lane >> 4) & 1) << 5) | (((lane >> 5) & 1) << 8); }
template <int DK> __device__ __forceinline__ int k_st(int row, int ch) { return row * (DK * 2) + ((ch ^ (row & 7)) << 4); }

template <int DK, bool BIAS>
__device__ __forceinline__ void qkt(f32x16& p0, f32x16& p1, ATT_LAS const unsigned char* Kt, int r32, int hi, const bf16x8* qr, ATT_LAS const float* bp) {
    if constexpr (BIAS) {
#pragma unroll
        for (int g = 0; g < 4; ++g) { const f32x4 a = *(ATT_LAS const f32x4*)(bp + 8 * g), b = *(ATT_LAS const f32x4*)(bp + 32 + 8 * g);
            p0[4 * g] = a[0]; p0[4 * g + 1] = a[1]; p0[4 * g + 2] = a[2]; p0[4 * g + 3] = a[3]; p1[4 * g] = b[0]; p1[4 * g + 1] = b[1]; p1[4 * g + 2] = b[2]; p1[4 * g + 3] = b[3]; }
    } else { p0 = f32x16{}; p1 = f32x16{}; }
    ATT_LAS const unsigned char* kb[4];
#pragma unroll
    for (int dd = 0; dd < 4; ++dd) kb[dd] = Kt + r32 * (DK * 2) + (((2 * dd + hi) ^ (r32 & 7)) << 4);
#pragma unroll
    for (int d0 = 0; d0 < DK / 16; ++d0) { ATT_LAS const unsigned char* a = kb[d0 & 3] + (d0 >> 2) * 128;
        const bf16x8 b0 = *(ATT_LAS const bf16x8*)a;
        const bf16x8 b1 = *(ATT_LAS const bf16x8*)(a + 32 * DK * 2);
        p0 = __builtin_amdgcn_mfma_f32_32x32x16_bf16(b0, qr[d0], p0, 0, 0, 0);
        p1 = __builtin_amdgcn_mfma_f32_32x32x16_bf16(b1, qr[d0], p1, 0, 0, 0); }
}
template <int DV>
__device__ __forceinline__ void pv_tile(f32x16* o, int vb0, bf16x8 pa0, bf16x8 pa1, bf16x8 pa2, bf16x8 pa3) {
    constexpr int NS = DV / 32, HS = NS * 512, KS = 2 * HS;
#define ATT_TRRD(dst, off) asm volatile("ds_read_b64_tr_b16 %0, %1 offset:%2" : "=&v"(dst) : "v"(vb0), "i"(off) : "memory")
#pragma unroll
    for (int d0 = 0; d0 < NS; ++d0) { s16x4 l0, l1, l2, l3, h0, h1, h2, h3;
        switch (d0) {
        case 0: ATT_TRRD(l0, 0 * 512); ATT_TRRD(h0, 0 * 512 + HS); ATT_TRRD(l1, 0 * 512 + KS); ATT_TRRD(h1, 0 * 512 + KS + HS); ATT_TRRD(l2, 0 * 512 + 2 * KS); ATT_TRRD(h2, 0 * 512 + 2 * KS + HS); ATT_TRRD(l3, 0 * 512 + 3 * KS); ATT_TRRD(h3, 0 * 512 + 3 * KS + HS); break;
        case 1: ATT_TRRD(l0, 1 * 512); ATT_TRRD(h0, 1 * 512 + HS); ATT_TRRD(l1, 1 * 512 + KS); ATT_TRRD(h1, 1 * 512 + KS + HS); ATT_TRRD(l2, 1 * 512 + 2 * KS); ATT_TRRD(h2, 1 * 512 + 2 * KS + HS); ATT_TRRD(l3, 1 * 512 + 3 * KS); ATT_TRRD(h3, 1 * 512 + 3 * KS + HS); break;
        case 2: ATT_TRRD(l0, 2 * 512); ATT_TRRD(h0, 2 * 512 + HS); ATT_TRRD(l1, 2 * 512 + KS); ATT_TRRD(h1, 2 * 512 + KS + HS); ATT_TRRD(l2, 2 * 512 + 2 * KS); ATT_TRRD(h2, 2 * 512 + 2 * KS + HS); ATT_TRRD(l3, 2 * 512 + 3 * KS); ATT_TRRD(h3, 2 * 512 + 3 * KS + HS); break;
        default: ATT_TRRD(l0, 3 * 512); ATT_TRRD(h0, 3 * 512 + HS); ATT_TRRD(l1, 3 * 512 + KS); ATT_TRRD(h1, 3 * 512 + KS + HS); ATT_TRRD(l2, 3 * 512 + 2 * KS); ATT_TRRD(h2, 3 * 512 + 2 * KS + HS); ATT_TRRD(l3, 3 * 512 + 3 * KS); ATT_TRRD(h3, 3 * 512 + 3 * KS + HS); break;
        }
        asm volatile("s_waitcnt lgkmcnt(0)" ::: "memory"); ATT_SBAR();
        o[d0] = __builtin_amdgcn_mfma_f32_32x32x16_bf16(pa0, (bf16x8){l0[0], l0[1], l0[2], l0[3], h0[0], h0[1], h0[2], h0[3]}, o[d0], 0, 0, 0);
        o[d0] = __builtin_amdgcn_mfma_f32_32x32x16_bf16(pa1, (bf16x8){l1[0], l1[1], l1[2], l1[3], h1[0], h1[1], h1[2], h1[3]}, o[d0], 0, 0, 0);
        o[d0] = __builtin_amdgcn_mfma_f32_32x32x16_bf16(pa2, (bf16x8){l2[0], l2[1], l2[2], l2[3], h2[0], h2[1], h2[2], h2[3]}, o[d0], 0, 0, 0);
        o[d0] = __builtin_amdgcn_mfma_f32_32x32x16_bf16(pa3, (bf16x8){l3[0], l3[1], l3[2], l3[3], h3[0], h3[1], h3[2], h3[3]}, o[d0], 0, 0, 0); }
#undef ATT_TRRD
}

template <int ND>
__device__ __forceinline__ void attn_epilogue(const f32x16* o, float l_reg, ATT_LAS float* li_l, ATT_LAS float* stage, const bf16_t* Zrow0, bf16_t* Orow0, int lane) {
    const int r32 = lane & 31, hi = lane >> 5;
    if (hi == 0) li_l[r32] = l_reg;
    asm volatile("s_waitcnt lgkmcnt(0)" ::: "memory");
    float rl[16];
#pragma unroll
    for (int g = 0; g < 4; ++g) { const f32x4 l4 = *(ATT_LAS const f32x4*)(li_l + 8 * g + 4 * hi);
#pragma unroll
        for (int e = 0; e < 4; ++e) rl[4 * g + e] = __builtin_amdgcn_rcpf(l4[e]); }
#pragma unroll
    for (int half = 0; half < ND / 2; ++half) {
#pragma unroll
        for (int dd = 0; dd < 2; ++dd)
#pragma unroll
            for (int r = 0; r < 16; ++r) stage[((r & 3) + 8 * (r >> 2) + 4 * hi) * 68 + dd * 32 + r32] = o[2 * half + dd][r] * rl[r];
        asm volatile("s_waitcnt lgkmcnt(0)" ::: "memory");
#pragma unroll
        for (int j = 0; j < 4; ++j) { const int id = lane + 64 * j, row = id >> 3, cg = id & 7;
            const f32x4 a0 = *(ATT_LAS const f32x4*)(stage + row * 68 + cg * 8), a1 = *(ATT_LAS const f32x4*)(stage + row * 68 + cg * 8 + 4);
            const size_t off = (size_t)row * 2048 + half * 64 + cg * 8, offo = (size_t)row * OPITCH + half * 64 + cg * 8;
            const u32x4 zz = *(const u32x4*)(Zrow0 + off);
            float z[8] = {__uint_as_float(zz.x << 16), __uint_as_float(zz.x & 0xffff0000u), __uint_as_float(zz.y << 16), __uint_as_float(zz.y & 0xffff0000u),
                          __uint_as_float(zz.z << 16), __uint_as_float(zz.z & 0xffff0000u), __uint_as_float(zz.w << 16), __uint_as_float(zz.w & 0xffff0000u)};
            float v[8] = {a0[0], a0[1], a0[2], a0[3], a1[0], a1[1], a1[2], a1[3]};
#pragma unroll
            for (int e = 0; e < 8; ++e) v[e] = v[e] * z[e] * __builtin_amdgcn_rcpf(1.0f + __builtin_amdgcn_exp2f(-LOG2E * z[e]));
            u32x4 w = {cvtpk(v[0], v[1]), cvtpk(v[2], v[3]), cvtpk(v[4], v[5]), cvtpk(v[6], v[7])};
            *(u32x4*)(Orow0 + offo) = w; }
        asm volatile("s_waitcnt lgkmcnt(0)" ::: "memory");
    }
}

template <int KIND, int VAR = 0, int ORDER = 0>
__device__ __forceinline__ void attn_unit_o(const Args& T, int b, int h, int qb, ATT_LAS unsigned char* lds) {
    typedef Cfg<KIND> C; constexpr int DK = C::DK, DV = C::DV, QP = C::QP, KP = C::KP, VP = C::VP, NQF = DK / 16, ND = DV / 32;
    constexpr int KROW = DK * 2, KBUF = 64 * KROW, VBUF = 64 * DV * 2, LK = 0, LV = 3 * KBUF, LWS = LV + 3 * VBUF, LTAB = LWS + 8 * 256, LEND = LTAB + (KIND == 2 ? 8192 : 0);
    constexpr int NDK = KBUF / 8192, NDV = VBUF / 8192, NDMA = NDK + NDV;
    static_assert(LEND <= 131072 && KIND != 1, "attention LDS");
    int tid_l = threadIdx.x; asm volatile("" : "+v"(tid_l));
    const int tid = tid_l, wid = __builtin_amdgcn_readfirstlane(tid >> 6), lane = tid & 63, r32 = lane & 31, hi = lane >> 5;
    const int P0 = qb * QB;
    const size_t tok0 = (size_t)b * SEQ;
    const int j_hi = (P0 + QB) / KVBLK;
    const int qlo = P0 + wid * 32, qpos = qlo + r32;
    ATT_LAS unsigned char* K_lds = lds + LK; ATT_LAS unsigned char* V_lds = lds + LV;
    ATT_LAS float* wsf = (ATT_LAS float*)(lds + LWS) + wid * 64; ATT_LAS float* li_l = wsf; ATT_LAS float* al_l = wsf + 32;
    ATT_LAS float* tab = (ATT_LAS float*)(lds + LTAB);
    const int vb0 = (int)(unsigned)(uintptr_t)V_lds + v_rd_base(lane);
    const bf16_t* Kg = T.K + tok0 * KP + h * (KIND == 0 ? 128 : DK);
    const bf16_t* Vg = T.V + tok0 * VP + h * DV;
    const bf16_t* KRg = T.KR + tok0 * 64;
    int ksrc[NDK]; bool kro[NDK]; int vsrc[NDV];
#pragma unroll
    for (int i = 0; i < NDK; ++i) {
        if constexpr (KIND == 2) { const int row = 4 * (wid * NDK + i) + (lane >> 4), c = (lane & 15) ^ (row & 15); ksrc[i] = row * KP + c * 8; kro[i] = false; }
        else { const int q = 64 * (wid * NDK + i) + lane, row = q / 24, slot = q - row * 24, gs = slot >> 3, c = gs * 8 + ((slot & 7) ^ ((row >> 1) & 7));
               kro[i] = gs == 2; ksrc[i] = kro[i] ? row * 64 + (c - 16) * 8 : row * KP + c * 8; }
    }
#pragma unroll
    for (int i = 0; i < NDV; ++i) { const int S = 2 * (wid * NDV + i) + (lane >> 5), kk = (S >> 2) * 8 + ((lane & 31) >> 2), k = (kk & ~0xC) | ((kk & 4) << 1) | ((kk & 8) >> 1);
        vsrc[i] = k * VP + (S & 3) * 32 + (lane & 3) * 8; }
#define ATT_DMAK(tile_) do { const int tl_ = (tile_) < j_hi ? (tile_) : j_hi - 1; const int bf_ = tl_ % 3; _Pragma("unroll") for (int i_ = 0; i_ < NDK; ++i_) { \
        const bf16_t* sp_ = (KIND == 0 && kro[i_]) ? KRg + (size_t)tl_ * KVBLK * 64 + ksrc[i_] : Kg + (size_t)tl_ * KVBLK * KP + ksrc[i_]; \
        __builtin_amdgcn_global_load_lds((const unsigned*)sp_, (ATT_LAS unsigned*)(K_lds + bf_ * KBUF + (wid * NDK + i_) * 1024), 16, 0, 0); } } while (0)
#define ATT_DMAV(tile_) do { const int tl_ = (tile_) < j_hi ? (tile_) : j_hi - 1; const int bf_ = tl_ % 3; _Pragma("unroll") for (int i_ = 0; i_ < NDV; ++i_) \
        __builtin_amdgcn_global_load_lds((const unsigned*)(Vg + (size_t)tl_ * KVBLK * VP + vsrc[i_]), (ATT_LAS unsigned*)(V_lds + bf_ * VBUF + (wid * NDV + i_) * 1024), 16, 0, 0); } while (0)
    const int kl0 = r32 * KROW + ((hi ^ (KIND == 2 ? (r32 & 15) : ((r32 >> 1) & 7))) << 4);
#define ATT_KFRAG(dst, d0_) do { const int ko_ = (kl0 ^ (((d0_) & (KIND == 2 ? 7 : 3)) << 5)) + (KIND == 2 ? 0 : ((d0_) >> 2) * 128); \
        dst[0] = *(ATT_LAS const bf16x8*)(kt_ + ko_); dst[1] = *(ATT_LAS const bf16x8*)(kt_ + ko_ + 32 * KROW); } while (0)
#define ATT_QKT(PX0, PX1, kbf_, kb_) do { \
        ATT_LAS const unsigned char* kt_ = K_lds + (kbf_) * KBUF; \
        bf16x8 kfa_[2], kfb_[2]; \
        ATT_KFRAG(kfa_, 0); ATT_KFRAG(kfb_, 1); \
        if constexpr (KIND == 2) { ATT_LAS const float* bp = tab + (kb_) + 4 * hi; _Pragma("unroll") for (int g = 0; g < 4; ++g) { const f32x4 a_ = *(ATT_LAS const f32x4*)(bp + 8 * g), b_ = *(ATT_LAS const f32x4*)(bp + 32 + 8 * g); \
                PX0[4 * g] = a_[0]; PX0[4 * g + 1] = a_[1]; PX0[4 * g + 2] = a_[2]; PX0[4 * g + 3] = a_[3]; PX1[4 * g] = b_[0]; PX1[4 * g + 1] = b_[1]; PX1[4 * g + 2] = b_[2]; PX1[4 * g + 3] = b_[3]; } } \
        else { PX0 = f32x16{}; PX1 = f32x16{}; } \
        _Pragma("unroll") for (int d0 = 0; d0 < NQF; d0 += 2) { \
            PX0 = __builtin_amdgcn_mfma_f32_32x32x16_bf16(kfa_[0], qr[d0], PX0, 0, 0, 0); PX1 = __builtin_amdgcn_mfma_f32_32x32x16_bf16(kfa_[1], qr[d0], PX1, 0, 0, 0); \
            if (d0 + 2 < NQF) ATT_KFRAG(kfa_, d0 + 2); \
            ATT_SBAR(); \
            PX0 = __builtin_amdgcn_mfma_f32_32x32x16_bf16(kfb_[0], qr[d0 + 1], PX0, 0, 0, 0); PX1 = __builtin_amdgcn_mfma_f32_32x32x16_bf16(kfb_[1], qr[d0 + 1], PX1, 0, 0, 0); \
            if (d0 + 3 < NQF) ATT_KFRAG(kfb_, d0 + 3); \
            ATT_SBAR(); } } while (0)
#define ATT_ACT(kb_) ((kb_) <= qlo + 31)
    ATT_DMAK(0); ATT_DMAV(0); ATT_DMAK(1); ATT_DMAV(1); ATT_DMAK(2);
    bf16x8 qr[NQF];
    { const bf16_t* Qw = T.Q + (tok0 + qpos) * QP + h * DK + hi * 8;
#pragma unroll
      for (int d0 = 0; d0 < NQF; ++d0) qr[d0] = *(const bf16x8*)(Qw + d0 * 16); }
    if constexpr (KIND == 2) { const float* cb = T.CB + ((size_t)b * 16 + h) * SEQ; for (int i = tid; i < P0 + QB; i += 512) tab[i] = cb[i]; }
    float m_reg = -1e30f, l_reg = 0.f;
    f32x16 o[ND];
#pragma unroll
    for (int d = 0; d < ND; ++d) o[d] = f32x16{};
    asm volatile("s_waitcnt vmcnt(0)" ::: "memory");
    __syncthreads();
#define ATT_PK4(P, B_, OUT) do { unsigned a0 = cvtpk(P[B_ + 0], P[B_ + 1]), a1 = cvtpk(P[B_ + 2], P[B_ + 3]); \
            unsigned b0 = cvtpk(P[B_ + 4], P[B_ + 5]), b1 = cvtpk(P[B_ + 6], P[B_ + 7]); \
            auto r0 = __builtin_amdgcn_permlane32_swap(a0, b0, false, false); auto r1 = __builtin_amdgcn_permlane32_swap(a1, b1, false, false); \
            u32x4 w = {r0[0], r1[0], r0[1], r1[1]}; OUT = __builtin_bit_cast(bf16x8, w); } while (0)
#define ATT_STEP(PC0, PC1, PN0, PN1, t_) do { \
        const int t = (t_); const int kb = t * KVBLK, vbf = t % 3, kbn = (t + 1) % 3; \
        ATT_DMAK(t + 3); ATT_DMAV(t + 2); \
        ATT_SBAR(); \
        const bool actn = (t + 1 < j_hi) && ATT_ACT(kb + KVBLK); \
        if constexpr (ORDER == 0) { \
        if (actn) { if constexpr (VAR == 3 || VAR == 4) { PN0 = f32x16{}; PN1 = f32x16{}; } else ATT_QKT(PN0, PN1, kbn, kb + KVBLK); } \
        ATT_SBAR(); \
        if (VAR != 4 && ATT_ACT(kb)) { \
            const int dq = qpos - kb - 4 * hi; \
            if (kb + KVBLK - 1 > qlo) { const float NEG = -__builtin_inff(); \
_Pragma("unroll") \
                for (int r = 0; r < 16; ++r) { const int c = (r & 3) + 8 * (r >> 2); \
                    if (dq - c < 0) PC0[r] = NEG; \
                    if (dq - c - 32 < 0) PC1[r] = NEG; } } \
            if constexpr (VAR != 1) { \
            float pmax = PC0[0]; \
_Pragma("unroll") \
            for (int r = 1; r < 16; ++r) pmax = fmaxf(pmax, PC0[r]); \
_Pragma("unroll") \
            for (int r = 0; r < 16; ++r) pmax = fmaxf(pmax, PC1[r]); \
            { auto rr = __builtin_amdgcn_permlane32_swap(__float_as_uint(pmax), __float_as_uint(pmax), false, false); \
              pmax = fmaxf(__uint_as_float(rr[0]), __uint_as_float(rr[1])); } \
            const float mn = fmaxf(m_reg, pmax); \
            const float alpha = __builtin_amdgcn_exp2f(m_reg - mn); \
            m_reg = mn; \
            float ps = 0.f; \
_Pragma("unroll") \
            for (int r = 0; r < 16; ++r) { PC0[r] = __builtin_amdgcn_exp2f(PC0[r] - mn); ps += PC0[r]; } \
_Pragma("unroll") \
            for (int r = 0; r < 16; ++r) { PC1[r] = __builtin_amdgcn_exp2f(PC1[r] - mn); ps += PC1[r]; } \
            { auto rr = __builtin_amdgcn_permlane32_swap(__float_as_uint(ps), __float_as_uint(ps), false, false); \
              ps = __uint_as_float(rr[0]) + __uint_as_float(rr[1]); } \
            l_reg = l_reg * alpha + ps; \
            if (__any(alpha < 1.f)) { \
                if (hi == 0) al_l[r32] = alpha; \
                asm volatile("s_waitcnt lgkmcnt(0)" ::: "memory"); \
_Pragma("unroll") \
                for (int g = 0; g < 4; ++g) { const f32x4 a4 = *(ATT_LAS const f32x4*)(al_l + 8 * g + 4 * hi); \
_Pragma("unroll") \
                    for (int d = 0; d < ND; ++d) { o[d][4 * g] *= a4[0]; o[d][4 * g + 1] *= a4[1]; o[d][4 * g + 2] *= a4[2]; o[d][4 * g + 3] *= a4[3]; } } \
            } \
            } \
            bf16x8 pa0, pa1, pa2, pa3; \
            ATT_PK4(PC0, 0, pa0); ATT_PK4(PC0, 8, pa1); ATT_PK4(PC1, 0, pa2); ATT_PK4(PC1, 8, pa3); \
            if constexpr (VAR != 2) pv_tile<DV>(o, vb0 + vbf * VBUF, pa0, pa1, pa2, pa3); else { o[0][0] += __builtin_bit_cast(float, pa0[0] + pa1[1] + pa2[2] + pa3[3]) * 1e-30f; } \
        } \
        } else { \
        if (VAR != 4 && ATT_ACT(kb)) { \
            const int dq = qpos - kb - 4 * hi; \
            if (kb + KVBLK - 1 > qlo) { const float NEG = -__builtin_inff(); \
_Pragma("unroll") \
                for (int r = 0; r < 16; ++r) { const int c = (r & 3) + 8 * (r >> 2); \
                    if (dq - c < 0) PC0[r] = NEG; \
                    if (dq - c - 32 < 0) PC1[r] = NEG; } } \
            if constexpr (VAR != 1) { \
            float pmax = PC0[0]; \
_Pragma("unroll") \
            for (int r = 1; r < 16; ++r) pmax = fmaxf(pmax, PC0[r]); \
_Pragma("unroll") \
            for (int r = 0; r < 16; ++r) pmax = fmaxf(pmax, PC1[r]); \
            { auto rr = __builtin_amdgcn_permlane32_swap(__float_as_uint(pmax), __float_as_uint(pmax), false, false); \
              pmax = fmaxf(__uint_as_float(rr[0]), __uint_as_float(rr[1])); } \
            const float mn = fmaxf(m_reg, pmax); \
            const float alpha = __builtin_amdgcn_exp2f(m_reg - mn); \
            m_reg = mn; \
            float ps = 0.f; \
_Pragma("unroll") \
            for (int r = 0; r < 16; ++r) { PC0[r] = __builtin_amdgcn_exp2f(PC0[r] - mn); ps += PC0[r]; } \
_Pragma("unroll") \
            for (int r = 0; r < 16; ++r) { PC1[r] = __builtin_amdgcn_exp2f(PC1[r] - mn); ps += PC1[r]; } \
            { auto rr = __builtin_amdgcn_permlane32_swap(__float_as_uint(ps), __float_as_uint(ps), false, false); \
              ps = __uint_as_float(rr[0]) + __uint_as_float(rr[1]); } \
            l_reg = l_reg * alpha + ps; \
            if (__any(alpha < 1.f)) { \
                if (hi == 0) al_l[r32] = alpha; \
                asm volatile("s_waitcnt lgkmcnt(0)" ::: "memory"); \
_Pragma("unroll") \
                for (int g = 0; g < 4; ++g) { const f32x4 a4 = *(ATT_LAS const f32x4*)(al_l + 8 * g + 4 * hi); \
_Pragma("unroll") \
                    for (int d = 0; d < ND; ++d) { o[d][4 * g] *= a4[0]; o[d][4 * g + 1] *= a4[1]; o[d][4 * g + 2] *= a4[2]; o[d][4 * g + 3] *= a4[3]; } } \
            } \
            } \
            bf16x8 pa0, pa1, pa2, pa3; \
            ATT_PK4(PC0, 0, pa0); ATT_PK4(PC0, 8, pa1); ATT_PK4(PC1, 0, pa2); ATT_PK4(PC1, 8, pa3); \
            if constexpr (VAR != 2) pv_tile<DV>(o, vb0 + vbf * VBUF, pa0, pa1, pa2, pa3); else { o[0][0] += __builtin_bit_cast(float, pa0[0] + pa1[1] + pa2[2] + pa3[3]) * 1e-30f; } \
        } \
        ATT_SBAR(); \
        if (actn) { if constexpr (VAR == 3 || VAR == 4) { PN0 = f32x16{}; PN1 = f32x16{}; } else ATT_QKT(PN0, PN1, kbn, kb + KVBLK); } \
        } \
        ATT_SBAR(); \
        asm volatile("s_waitcnt vmcnt(%0) lgkmcnt(0)" :: "n"(NDMA) : "memory");        \
        __builtin_amdgcn_s_barrier(); asm volatile("" ::: "memory"); \
    } while (0)
    f32x16 pA0, pA1, pB0, pB1;
    ATT_QKT(pA0, pA1, 0, 0);
    __syncthreads();
    for (int tt = 0; tt < j_hi; tt += 2) {
        ATT_STEP(pA0, pA1, pB0, pB1, tt);
        ATT_STEP(pB0, pB1, pA0, pA1, tt + 1);
    }
#undef ATT_STEP
#undef ATT_PK4
    asm volatile("s_waitcnt vmcnt(0)" ::: "memory");
    __syncthreads();
    { const size_t ro = (tok0 + P0 + wid * 32) * 2048 + (size_t)h * DV, roo = (tok0 + P0 + wid * 32) * OPITCH + (size_t)h * DV;
      attn_epilogue<ND>(o, l_reg, li_l, (ATT_LAS float*)(lds + wid * 8704), T.Z + ro, T.O + roo, lane); }
    __syncthreads();
#undef ATT_DMAK
#undef ATT_DMAV
#undef ATT_QKT
#undef ATT_KFRAG
#undef ATT_ACT
}

template <int KIND, int VAR = 0>
__device__ __forceinline__ void attn_unit(const Args& T, int b, int h, int qb, ATT_LAS unsigned char* lds) {
    const int wv = __builtin_amdgcn_readfirstlane((int)threadIdx.x >> 6);
    if (wv < ATT_SPLIT) attn_unit_o<KIND, VAR, 0>(T, b, h, qb, lds); else attn_unit_o<KIND, VAR, 1>(T, b, h, qb, lds);
}

constexpr int LB_KROW = 144, LB_K = 0, LB_V = 384 * LB_KROW, LB_TAB = LB_V + 6 * 8192, LB_TABN = 320  , LB_WS = LB_TAB + 8 * LB_TABN * 4, LB_ST = LB_WS + 8 * 256  , LB_END = LB_ST + 8 * 2560;
__device__ __forceinline__ void attn_unit_b(const Args& T, int b, int kvh, int qb, ATT_LAS unsigned char* lds) {
    constexpr int QP = 2048, KP = 256;
    int tid_l = threadIdx.x; asm volatile("" : "+v"(tid_l));
    const int tid = tid_l, wid = __builtin_amdgcn_readfirstlane(tid >> 6), lane = tid & 63, r32 = lane & 31, hi = lane >> 5;
    const int P0 = qb * QB; const size_t tok0 = (size_t)b * SEQ;
    const int j_lo = P0 >= QB ? (P0 - 128) / KVBLK : 0, NT = (P0 + QB) / KVBLK - j_lo, kb0 = j_lo * KVBLK;
    const int qlo = P0 + wid * 32, qpos = qlo + r32;
    ATT_LAS unsigned char* K_lds = lds + LB_K; ATT_LAS unsigned char* V_lds = lds + LB_V;
    ATT_LAS float* wsf = (ATT_LAS float*)(lds + LB_WS) + wid * 64; ATT_LAS float* li_l = wsf; ATT_LAS float* al_l = wsf + 32;
    const int vb0 = (int)(unsigned)(uintptr_t)V_lds + v_rd_base(lane);
    {
        const bf16_t* Kg = T.K + (tok0 + kb0) * KP + kvh * 64; const bf16_t* Vg = T.V + (tok0 + kb0) * KP + kvh * 64;
        const int sr8 = tid >> 3, sc8 = tid & 7;
        bf16x8 sk[6], sv[6];
#pragma unroll
        for (int i = 0; i < 6; ++i) if (i < NT) { sk[i] = *(const bf16x8*)(Kg + (size_t)(64 * i + sr8) * KP + sc8 * 8); sv[i] = *(const bf16x8*)(Vg + (size_t)(64 * i + sr8) * KP + sc8 * 8); }
        for (int j = tid; j < 8 * LB_TABN; j += 512) { const int g = j / LB_TABN, e = j - g * LB_TABN + 160, d = 383 - e; float v = 0.f;
            if (d >= 0 && d < 128) { int bk = d; if (d >= 16) { bk = 16 + (int)(__logf((float)d * (1.0f / 16.0f)) / 2.0794415416798357f * 16.0f); bk = bk > 31 ? 31 : bk; } v = T.relt[bk * 32 + kvh * 8 + g] * LOG2E; }
            ((ATT_LAS float*)(lds + LB_TAB))[j] = v; }
#pragma unroll
        for (int i = 0; i < 6; ++i) if (i < NT) { *(ATT_LAS bf16x8*)(K_lds + (64 * i + sr8) * LB_KROW + sc8 * 16) = sk[i]; *(ATT_LAS bf16x8*)(V_lds + i * 8192 + v_st<64>(sr8, sc8 * 8)) = sv[i]; }
    }
    __syncthreads();
    bf16x8 qn[4];
    { const bf16_t* Qw = T.Q + (tok0 + qpos) * QP + (kvh * 8) * 64 + hi * 8;
#pragma unroll
      for (int d0 = 0; d0 < 4; ++d0) qn[d0] = *(const bf16x8*)(Qw + d0 * 16); }
    for (int g = 0; g < 8; ++g) {
        const int h = kvh * 8 + g;
        bf16x8 qr[4];
#pragma unroll
        for (int d0 = 0; d0 < 4; ++d0) qr[d0] = qn[d0];
        if (g < 7) { const bf16_t* Qw = T.Q + (tok0 + qpos) * QP + (h + 1) * 64 + hi * 8;
#pragma unroll
            for (int d0 = 0; d0 < 4; ++d0) qn[d0] = *(const bf16x8*)(Qw + d0 * 16); }
        ATT_LAS const float* tabg = (ATT_LAS const float*)(lds + LB_TAB) + g * LB_TABN - 160;
        float m_reg = T.sinks[h] * LOG2E, l_reg = 1.f;
        f32x16 o[2]; o[0] = f32x16{}; o[1] = f32x16{};
        for (int t = 0; t < NT; ++t) {
            const int kb = kb0 + t * KVBLK;
            if (!(kb <= qlo + 31 && kb + KVBLK - 1 >= qlo - 127)) continue;
            f32x16 p0 = f32x16{}, p1 = f32x16{};
            { ATT_LAS const unsigned char* ka = K_lds + (t * 64 + r32) * LB_KROW + hi * 16;
#pragma unroll
              for (int d0 = 0; d0 < 4; ++d0) { const bf16x8 b0 = *(ATT_LAS const bf16x8*)(ka + d0 * 32), b1 = *(ATT_LAS const bf16x8*)(ka + d0 * 32 + 32 * LB_KROW);
                  p0 = __builtin_amdgcn_mfma_f32_32x32x16_bf16(b0, qr[d0], p0, 0, 0, 0); p1 = __builtin_amdgcn_mfma_f32_32x32x16_bf16(b1, qr[d0], p1, 0, 0, 0); } }
            const int dq = qpos - kb - 4 * hi;
            { ATT_LAS const float* tp = tabg + (383 - dq); const float NEG = -__builtin_inff();
#pragma unroll
              for (int r = 0; r < 16; ++r) { const int c = (r & 3) + 8 * (r >> 2); p0[r] += tp[c]; p1[r] += tp[c + 32];
                  if ((unsigned)(dq - c) >= 128u) p0[r] = NEG;
                  if ((unsigned)(dq - c - 32) >= 128u) p1[r] = NEG; } }
            float pmax = p0[0];
#pragma unroll
            for (int r = 1; r < 16; ++r) pmax = fmaxf(pmax, p0[r]);
#pragma unroll
            for (int r = 0; r < 16; ++r) pmax = fmaxf(pmax, p1[r]);
            { auto rr = __builtin_amdgcn_permlane32_swap(__float_as_uint(pmax), __float_as_uint(pmax), false, false); pmax = fmaxf(__uint_as_float(rr[0]), __uint_as_float(rr[1])); }
            const float mn = fmaxf(m_reg, pmax), alpha = __builtin_amdgcn_exp2f(m_reg - mn);
            m_reg = mn;
            float ps = 0.f;
#pragma unroll
            for (int r = 0; r < 16; ++r) { p0[r] = __builtin_amdgcn_exp2f(p0[r] - mn); ps += p0[r]; }
#pragma unroll
            for (int r = 0; r < 16; ++r) { p1[r] = __builtin_amdgcn_exp2f(p1[r] - mn); ps += p1[r]; }
            { auto rr = __builtin_amdgcn_permlane32_swap(__float_as_uint(ps), __float_as_uint(ps), false, false); ps = __uint_as_float(rr[0]) + __uint_as_float(rr[1]); }
            l_reg = l_reg * alpha + ps;
            if (__any(alpha < 1.f)) {
                if (hi == 0) al_l[r32] = alpha;
                asm volatile("s_waitcnt lgkmcnt(0)" ::: "memory");
#pragma unroll
                for (int q = 0; q < 4; ++q) { const f32x4 a4 = *(ATT_LAS const f32x4*)(al_l + 8 * q + 4 * hi);
#pragma unroll
                    for (int d = 0; d < 2; ++d) { o[d][4 * q] *= a4[0]; o[d][4 * q + 1] *= a4[1]; o[d][4 * q + 2] *= a4[2]; o[d][4 * q + 3] *= a4[3]; } }
            }
            bf16x8 pa0, pa1, pa2, pa3;
#define ATT_PK4(P, B_, OUT) do { unsigned a0 = cvtpk(P[B_ + 0], P[B_ + 1]), a1 = cvtpk(P[B_ + 2], P[B_ + 3]); \
            unsigned b0 = cvtpk(P[B_ + 4], P[B_ + 5]), b1 = cvtpk(P[B_ + 6], P[B_ + 7]); \
            auto r0 = __builtin_amdgcn_permlane32_swap(a0, b0, false, false); auto r1 = __builtin_amdgcn_permlane32_swap(a1, b1, false, false); \
            u32x4 w = {r0[0], r1[0], r0[1], r1[1]}; OUT = __builtin_bit_cast(bf16x8, w); } while (0)
            ATT_PK4(p0, 0, pa0); ATT_PK4(p0, 8, pa1); ATT_PK4(p1, 0, pa2); ATT_PK4(p1, 8, pa3);
#undef ATT_PK4
            pv_tile<64>(o, vb0 + t * 8192, pa0, pa1, pa2, pa3);
        }
        if (hi == 0) li_l[r32] = l_reg;
        asm volatile("s_waitcnt lgkmcnt(0)" ::: "memory");
        { float rl[16];
#pragma unroll
          for (int q = 0; q < 4; ++q) { const f32x4 l4 = *(ATT_LAS const f32x4*)(li_l + 8 * q + 4 * hi);
#pragma unroll
              for (int e = 0; e < 4; ++e) rl[4 * q + e] = __builtin_amdgcn_rcpf(l4[e]); }
          ATT_LAS unsigned short* stg = (ATT_LAS unsigned short*)(lds + LB_ST + wid * 2560);
          const size_t ro = (tok0 + P0 + wid * 32) * 2048 + (size_t)h * 64, roo = (tok0 + P0 + wid * 32) * OPITCH + (size_t)h * 64;
#pragma unroll
          for (int d0 = 0; d0 < 2; ++d0) {
#pragma unroll
              for (int r = 0; r < 16; ++r) stg[((r & 3) + 8 * (r >> 2) + 4 * hi) * 40 + r32] = (unsigned short)(cvtpk(o[d0][r] * rl[r], 0.f) & 0xffffu);
              asm volatile("s_waitcnt lgkmcnt(0)" ::: "memory");
#pragma unroll
              for (int j = 0; j < 2; ++j) { const int id = lane + 64 * j, row = id >> 2, cg = id & 3;
                  const u32x4 ov = *(ATT_LAS const u32x4*)(stg + row * 40 + cg * 8);
                  const size_t off = ro + (size_t)row * 2048 + d0 * 32 + cg * 8, offo = roo + (size_t)row * OPITCH + d0 * 32 + cg * 8;
                  const u32x4 zz = *(const u32x4*)(T.Z + off);
                  const unsigned ow[4] = {ov.x, ov.y, ov.z, ov.w}, zw[4] = {zz.x, zz.y, zz.z, zz.w}; unsigned res[4];
#pragma unroll
                  for (int e = 0; e < 4; ++e) { const float z0 = __uint_as_float(zw[e] << 16), z1 = __uint_as_float(zw[e] & 0xffff0000u), v0 = __uint_as_float(ow[e] << 16), v1 = __uint_as_float(ow[e] & 0xffff0000u);
                      res[e] = cvtpk(v0 * z0 * __builtin_amdgcn_rcpf(1.0f + __builtin_amdgcn_exp2f(-LOG2E * z0)), v1 * z1 * __builtin_amdgcn_rcpf(1.0f + __builtin_amdgcn_exp2f(-LOG2E * z1))); }
                  *(u32x4*)(T.O + offo) = (u32x4){res[0], res[1], res[2], res[3]}; }
              asm volatile("s_waitcnt lgkmcnt(0)" ::: "memory"); } }
        asm volatile("s_waitcnt lgkmcnt(0)" ::: "memory");
    }
    __syncthreads();
}
}
static_assert(att::LB_END <= LDSCTL_OFF, "attention LDS inside the ring region");

struct Args { const void* in[18]; float* out; unsigned char* ws; };
#ifndef PH_MASK
#define PH_MASK 0xffff
#endif
#define PH(k) ((PH_MASK >> (k)) & 1)
#ifndef DUP_MASK
#define DUP_MASK 0
#endif
#define REP(k) for (int rep_ = 0; rep_ < (((DUP_MASK >> (k)) & 1) ? 2 : 1); ++rep_)

__device__ __forceinline__ float wave_sum(float v) {
#pragma unroll
    for (int o = 1; o < 64; o <<= 1) v += __shfl_xor(v, o);
    return v;
}
__device__ __forceinline__ int ropeidx(int p) { const int j = p >> 3, e = p & 7; return e < 4 ? 4 * j + e : 32 + 4 * j + (e - 4); }

struct CvtJob { const float* W; const float* W2; const float* gain; bf16* WT; int K, N, N2, kind, op, ldo; };
template <bool NT = true>
__device__ __forceinline__ void cvt_load(const CvtJob& J, int item, int lane, int nblk, f32x4 (&r)[8]) {
    const int kb = item / nblk, nb = item - kb * nblk, k0 = 64 * kb + 8 * (lane & 7), n = 32 * nb + 4 * (lane >> 3);
    const float* src = J.W; int col = n, ld = J.N;
    if (J.kind == 6) {
        if (n < 1536) col = n; else if (n < 3584) col = 4160 + (n - 1536); else if (n < 3840) col = 6208 + (n - 3584); else if (n < 5888) col = 8768 + (n - 3840);
        else if (n < 7936) col = 10816 + (n - 5888); else if (n < 9984) col = 6720 + (n - 7936); else if (n < 12032) col = 2112 + (n - 9984); else if (n < 14080) col = 14928 + (n - 12032); else { src = J.W2; col = n - 14080; ld = J.N2; }
    } else if (J.kind == 7) {
        if (n < 512) col = 1536 + n; else if (n < 768) col = 6464 + (n - 512);
        else if (n < 2816) col = 12864 + (n - 768);
        else { const int lc = n - 2816; col = lc < 64 ? 2048 + ropeidx(lc) : (lc < 80 ? 14912 + (lc - 64) : -1); }
    } else if (J.kind == 1) { const int hh = n / 192, c = n - hh * 192; col = hh * 192 + (c < 128 ? c : 128 + ropeidx(c - 128)); }
    else if (J.kind == 2) { if (n >= 2048) { src = J.W2; col = n - 2048; } }
    const float* p = src + (size_t)k0 * ld + (col >= 0 ? col : 0);
#pragma unroll
    for (int i = 0; i < 8; ++i) { r[i] = (f32x4){0.f, 0.f, 0.f, 0.f}; if (col >= 0) { if constexpr (NT) r[i] = __builtin_nontemporal_load((const f32x4*)(p + (size_t)i * ld)); else r[i] = *(const f32x4*)(p + (size_t)i * ld); } }
}
__device__ __forceinline__ void cvt_store(const CvtJob& J, int item, int lane, int nblk, f32x4 (&r)[8]) {
    const int kb = item / nblk, nb = item - kb * nblk, k0 = 64 * kb + 8 * (lane & 7), n = 32 * nb + 4 * (lane >> 3);
    if (J.gain) { const f32x4 g0 = *(const f32x4*)(J.gain + k0), g1 = *(const f32x4*)(J.gain + k0 + 4);
        r[0] = r[0] * g0[0]; r[1] = r[1] * g0[1]; r[2] = r[2] * g0[2]; r[3] = r[3] * g0[3]; r[4] = r[4] * g1[0]; r[5] = r[5] * g1[1]; r[6] = r[6] * g1[2]; r[7] = r[7] * g1[3]; }
    const int ldo = J.ldo ? J.ldo : J.K;
    bf16* o = J.WT + (size_t)n * ldo + k0;
#pragma unroll
    for (int e = 0; e < 4; ++e) { v4u w; w.x = pk2(r[0][e], r[1][e]); w.y = pk2(r[2][e], r[3][e]); w.z = pk2(r[4][e], r[5][e]); w.w = pk2(r[6][e], r[7][e]);
        *(GAS v4u*)(o + (size_t)e * ldo) = w; }
}
typedef unsigned u32x4_t __attribute__((ext_vector_type(4)));
__device__ __forceinline__ int q8(float v, float inv) { return (int)rintf(v * inv) & 0xff; }
__device__ __forceinline__ void cvt_store8(const CvtJob& J, int item, int lane, int nblk, f32x4 (&r)[8]) {
    const int kb = item / nblk, nb = item - kb * nblk, k0 = 64 * kb + 8 * (lane & 7), n = 32 * nb + 4 * (lane >> 3);
    unsigned char* o = (unsigned char*)J.WT + (size_t)n * J.K + k0;
    const f32x4 cm = *(const f32x4*)(J.gain + n);
#pragma unroll
    for (int e = 0; e < 4; ++e) { const float inv = 127.0f / fmaxf(cm[e], 1e-30f);
        const unsigned w0 = (unsigned)q8(r[0][e], inv) | ((unsigned)q8(r[1][e], inv) << 8) | ((unsigned)q8(r[2][e], inv) << 16) | ((unsigned)q8(r[3][e], inv) << 24);
        const unsigned w1 = (unsigned)q8(r[4][e], inv) | ((unsigned)q8(r[5][e], inv) << 8) | ((unsigned)q8(r[6][e], inv) << 16) | ((unsigned)q8(r[7][e], inv) << 24);
        *(GAS unsigned long long*)(o + (size_t)e * J.K) = (unsigned long long)w0 | ((unsigned long long)w1 << 32); }
}
__device__ __forceinline__ void cvt_absmax(const CvtJob& J, int item, int lane, int nblk, const f32x4 (&r)[8]) {
    const int kb = item / nblk, nb = item - kb * nblk, n = 32 * nb + 4 * (lane >> 3); (void)kb;
    f32x4 mx = {0.f, 0.f, 0.f, 0.f};
#pragma unroll
    for (int i = 0; i < 8; ++i)
#pragma unroll
        for (int e = 0; e < 4; ++e) mx[e] = fmaxf(mx[e], fabsf(r[i][e]));
#pragma unroll
    for (int e = 0; e < 4; ++e) { mx[e] = fmaxf(mx[e], __shfl_xor(mx[e], 1)); mx[e] = fmaxf(mx[e], __shfl_xor(mx[e], 2)); mx[e] = fmaxf(mx[e], __shfl_xor(mx[e], 4)); }
    if ((lane & 7) == 0) {
#pragma unroll
        for (int e = 0; e < 4; ++e) atomicMax((unsigned*)J.WT + n + e, __float_as_uint(mx[e])); }
}
__device__ __forceinline__ void strip_pack(const f32x4 (&ra)[8], unsigned (&p)[16], f32x4& mx) {
#pragma unroll
    for (int r = 0; r < 8; ++r) {
#pragma unroll
        for (int e = 0; e < 4; ++e) mx[e] = fmaxf(mx[e], fabsf(ra[r][e]));
        p[2 * r] = pk2(ra[r][0], ra[r][1]); p[2 * r + 1] = pk2(ra[r][2], ra[r][3]); }
}
__device__ __forceinline__ void strip_quant(const unsigned (&pc)[16], const f32x4& inv, unsigned char* o, int K) {
#pragma unroll
    for (int e = 0; e < 4; ++e) { unsigned w[2] = {0u, 0u};
#pragma unroll
        for (int r = 0; r < 8; ++r) { const unsigned p = pc[2 * r + (e >> 1)]; const float v = (e & 1) ? __uint_as_float(p & 0xffff0000u) : __uint_as_float(p << 16);
            w[r >> 2] |= (unsigned)q8(v, inv[e]) << (8 * (r & 3)); }
        *(GAS unsigned long long*)(o + (size_t)e * K) = (unsigned long long)w[0] | ((unsigned long long)w[1] << 32); }
}
__device__ __forceinline__ void cvt_strip_i8(const CvtJob& J, int nb, int nblk, LAS unsigned* cmx, LAS unsigned char* hold, float* SB, int wave, int lane, int tid) {
    if (tid < 32) cmx[tid] = 0u;
    __syncthreads();
    const int n = 4 * (lane >> 3);
    LAS u32x4_t* hp = (LAS u32x4_t*)hold + tid;
    f32x4 mx = {0.f, 0.f, 0.f, 0.f};
    unsigned p0[16], p1[16], p2[16], p3[16];
    { f32x4 ra[8], rb[8]; cvt_load(J, (wave + 0) * nblk + nb, lane, nblk, ra); cvt_load(J, (wave + 8) * nblk + nb, lane, nblk, rb); strip_pack(ra, p0, mx); strip_pack(rb, p1, mx); }
    asm volatile("" ::: "memory");
    { f32x4 ra[8], rb[8]; cvt_load(J, (wave + 16) * nblk + nb, lane, nblk, ra); cvt_load(J, (wave + 24) * nblk + nb, lane, nblk, rb); strip_pack(ra, p2, mx); strip_pack(rb, p3, mx); }
    asm volatile("" ::: "memory");
#pragma unroll 1
    for (int i = 4; i < 8; i += 2) {
        f32x4 ra[8], rb[8]; cvt_load(J, (wave + 8 * i) * nblk + nb, lane, nblk, ra); cvt_load(J, (wave + 8 * i + 8) * nblk + nb, lane, nblk, rb);
        unsigned pa[16], pb[16]; strip_pack(ra, pa, mx); strip_pack(rb, pb, mx);
        LAS u32x4_t* hq = hp + (i - 4) * 4 * 512;
#pragma unroll
        for (int j = 0; j < 4; ++j) { hq[j * 512] = (u32x4_t){pa[4 * j], pa[4 * j + 1], pa[4 * j + 2], pa[4 * j + 3]}; hq[(4 + j) * 512] = (u32x4_t){pb[4 * j], pb[4 * j + 1], pb[4 * j + 2], pb[4 * j + 3]}; }
    }
#pragma unroll
    for (int e = 0; e < 4; ++e) { mx[e] = fmaxf(mx[e], __shfl_xor(mx[e], 1)); mx[e] = fmaxf(mx[e], __shfl_xor(mx[e], 2)); mx[e] = fmaxf(mx[e], __shfl_xor(mx[e], 4)); }
    if ((lane & 7) == 0) {
#pragma unroll
        for (int e = 0; e < 4; ++e) (void)__hip_atomic_fetch_max((unsigned*)(cmx + n + e), __float_as_uint(mx[e]), __ATOMIC_RELAXED, __HIP_MEMORY_SCOPE_WORKGROUP); }
    __syncthreads();
    f32x4 inv; { const u32x4_t c4 = *(LAS const u32x4_t*)(cmx + n);
#pragma unroll
        for (int e = 0; e < 4; ++e) inv[e] = 127.0f / fmaxf(__uint_as_float(c4[e]), 1e-30f); }
    if (tid < 32) SB[32 * nb + tid] = fmaxf(__uint_as_float(cmx[tid]), 1e-30f) * (1.0f / 127.0f);
    unsigned char* o = (unsigned char*)J.WT + (size_t)(32 * nb + n) * J.K + 64 * wave + 8 * (lane & 7);
    strip_quant(p0, inv, o, J.K); strip_quant(p1, inv, o + 512, J.K); strip_quant(p2, inv, o + 1024, J.K); strip_quant(p3, inv, o + 1536, J.K);
#pragma unroll 1
    for (int i = 4; i < 8; ++i) { unsigned pc[16]; LAS u32x4_t* hq = hp + (i - 4) * 4 * 512;
#pragma unroll
        for (int j = 0; j < 4; ++j) { const u32x4_t t4 = hq[j * 512]; pc[4 * j] = t4.x; pc[4 * j + 1] = t4.y; pc[4 * j + 2] = t4.z; pc[4 * j + 3] = t4.w; }
        strip_quant(pc, inv, o + 512 * i, J.K); }
    __syncthreads();
}
__device__ __forceinline__ void cvt_job(const CvtJob& J, int ndst, int gw, int ngw, int lane) {
    constexpr int NI = 4;
    const int nblk = ndst / 32, nitems = (J.K / 64) * nblk;
    for (int it = gw; it < nitems; it += NI * ngw) {
        f32x4 r[NI][8];
#pragma unroll
        for (int q = 0; q < NI; ++q) if (it + q * ngw < nitems) cvt_load(J, it + q * ngw, lane, nblk, r[q]);
#pragma unroll
        for (int q = 0; q < NI; ++q) if (it + q * ngw < nitems) {
            if (J.op == 4) cvt_store8(J, it + q * ngw, lane, nblk, r[q]);
            else if (J.op == 5) cvt_absmax(J, it + q * ngw, lane, nblk, r[q]);
            else cvt_store(J, it + q * ngw, lane, nblk, r[q]); }
    }
}

__device__ __forceinline__ float wave_max(float v) {
#pragma unroll
    for (int o = 1; o < 64; o <<= 1) v = fmaxf(v, __shfl_xor(v, o));
    return v;
}
__device__ __forceinline__ void rms_store_i8(f32x4 (&v)[16], const float* g, bf16* orow, unsigned char* orow8, float* sa, int lane) {
    float s = 0.f;
#pragma unroll
    for (int j = 0; j < 16; ++j) s += (v[j].x * v[j].x + v[j].y * v[j].y) + (v[j].z * v[j].z + v[j].w * v[j].w);
    const float rs = 1.0f / sqrtf(wave_sum(s) * (1.0f / DM) + 1e-6f);
    GAS unsigned* q8p = (GAS unsigned*)orow8 + lane; GAS unsigned long long* o8 = (GAS unsigned long long*)orow + lane;
    float mx = 0.f;
#pragma unroll
    for (int j = 0; j < 16; ++j) { const f32x4 gg = *((const GAS f32x4*)g + lane + 64 * j);
        v[j].x = v[j].x * rs * gg.x; v[j].y = v[j].y * rs * gg.y; v[j].z = v[j].z * rs * gg.z; v[j].w = v[j].w * rs * gg.w;
        mx = fmaxf(fmaxf(mx, fmaxf(fabsf(v[j].x), fabsf(v[j].y))), fmaxf(fabsf(v[j].z), fabsf(v[j].w)));
        o8[64 * j] = (unsigned long long)pk2(v[j].x, v[j].y) | ((unsigned long long)pk2(v[j].z, v[j].w) << 32); }
    mx = fmaxf(wave_max(mx), 1e-30f);
    const float inv = 127.0f / mx;
    if (lane == 0) sa[0] = mx * (1.0f / 127.0f);
#pragma unroll
    for (int j = 0; j < 16; ++j) q8p[64 * j] = (unsigned)q8(v[j].x, inv) | ((unsigned)q8(v[j].y, inv) << 8) | ((unsigned)q8(v[j].z, inv) << 16) | ((unsigned)q8(v[j].w, inv) << 24);
}

#define CONVERT_LAYER(LL) do { const int ll_ = (LL); unsigned char* wl = ws + WS_W + (size_t)ll_ * W_LAYER; \
        { constexpr int NSTRIP = N8 / 32; LAS unsigned* cmx = (LAS unsigned*)(lds + RING_OFF + RING_BYTES);   \
          for (int s = vcu; s < NSTRIP; s += G) { \
              CvtJob J{IN_F(4) + (size_t)ll_ * DM * NIN, IN_F(15) + (size_t)ll_ * DM * NMRG, nullptr, (bf16*)(wl + W_BIG), DM, NIN, NMRG, 6, 4}; \
              cvt_strip_i8(J, s, NSTRIP, cmx, lds + RING_OFF, (float*)(ws + WS_SB) + (size_t)ll_ * N8, wave, lane, tid); } } \
        { CvtJob J{IN_F(4) + (size_t)ll_ * DM * NIN, nullptr, nullptr, (bf16*)(wl + W_BIG16), DM, NIN, 0, 7, 0}; cvt_job(J, N16, gw, NGW, lane); } \
        { CvtJob J{IN_F(7) + (size_t)ll_ * 1536 * 3072, nullptr, IN_F(5) + ll_ * 1536, (bf16*)(wl + W_UQ), 1536, 3072, 0, 1, 0}; cvt_job(J, 3072, gw, NGW, lane); } \
        { CvtJob J{IN_F(8) + (size_t)ll_ * 512 * 2048, IN_F(9) + (size_t)ll_ * 512 * 2048, IN_F(6) + ll_ * 512, (bf16*)(wl + W_UKV), 512, 2048, 2048, 2, 0}; cvt_job(J, 4096, gw, NGW, lane); } \
          \
        { CvtJob J{IN_F(12) + (size_t)ll_ * 2048 * DM, nullptr, nullptr, (bf16*)(wl + W_PROJ), 2048, DM, 0, 3, 0, 6144}; cvt_job(J, DM, gw, NGW, lane); } \
        { CvtJob J{IN_F(13) + (size_t)ll_ * 2048 * DM, nullptr, nullptr, (bf16*)(wl + W_PROJ) + 2048, 2048, DM, 0, 3, 0, 6144}; cvt_job(J, DM, gw, NGW, lane); } \
        { CvtJob J{IN_F(14) + (size_t)ll_ * 2048 * DM, nullptr, nullptr, (bf16*)(wl + W_PROJ) + 4096, 2048, DM, 0, 3, 0, 6144}; cvt_job(J, DM, gw, NGW, lane); } \
        { CvtJob J{IN_F(16) + (size_t)ll_ * DM * DM, nullptr, nullptr, (bf16*)(wl + W_O), DM, DM, 0, 3, 0}; cvt_job(J, DM, gw, NGW, lane); } \
        __syncthreads(); } while (0)
#define KAS __attribute__((address_space(4)))
#define KARG(k) ({ const KAS char* kp_ = (const KAS char*)__builtin_amdgcn_kernarg_segment_ptr(); asm volatile("" : "+s"(kp_)); *(const void* const KAS*)(kp_ + 8 * (k)); })
#define IN_F(k) ((const float*)KARG(k))
#define WSP ((unsigned char*)KARG(19))
__global__ void __launch_bounds__(NWAVES * 64, 2) mk_fwd(Args args) {
    extern __shared__ __attribute__((aligned(16))) unsigned char lds_raw[];
    LAS unsigned char* lds = (LAS unsigned char*)lds_raw;
    volatile LAS unsigned* MISC = (volatile LAS unsigned*)(lds + MISC_OFF);
    const int G = gridDim.x, bx = blockIdx.x, vcu = (G % 8 == 0) ? (bx % 8) * (G / 8) + bx / 8 : bx;
    for (int u = threadIdx.x; u < (LDS_BYTES - LDSCTL_OFF) / 4; u += NWAVES * 64) ((LAS unsigned*)(lds + LDSCTL_OFF))[u] = 0u;
    __syncthreads();
    (void)xcd_barrier_post((unsigned*)((gu32*)(WSP + WS_CTL) + CW_BAR), MISC + 8);
#if defined(TEST_DOUBLE_BAR)
#define GRID_BAR() do { GRID_BAR1(); GRID_BAR1(); } while (0)
#else
#define GRID_BAR() GRID_BAR1()
#endif
#define GRID_BAR1() do { XcdBarrier b_; b_.bar = (unsigned*)((gu32*)(WSP + WS_CTL) + CW_BAR); b_.x = xb_xcc_id(); b_.st = MISC + 8; xcd_barrier(b_); } while (0)
    const int NGW = G * NWAVES;
#define PHASE_LOCALS() int tid_l = threadIdx.x; asm volatile("" : "+v"(tid_l)); const int tid = tid_l, lane = tid & 63, wave = __builtin_amdgcn_readfirstlane(tid >> 6), gw = vcu * NWAVES + wave; unsigned char* ws = WSP; (void)lane; (void)gw; (void)ws

    if (PH(0)) REP(0) {
        PHASE_LOCALS();
        CONVERT_LAYER(0);
        { float* ropeC = (float*)(ws + WS_ROPEC); float* ropeS = (float*)(ws + WS_ROPES); const int* positions = (const int*)KARG(1);
          for (int i = bx * 512 + tid; i < M * 32; i += G * 512) { const int m = i >> 5, k = i & 31;
            const float inv = exp2f(-(float)k * (13.287712379549449f / 32.0f));
            const float ang = (float)positions[m] * inv; float s, c; sincosf(ang, &s, &c); ropeC[i] = c; ropeS[i] = s; }
          unsigned long long* RS = (unsigned long long*)(ws + WS_RS);
          for (int i = bx * 512 + tid; i < 4 * M; i += G * 512) RS[i] = 0ull; }
        { const float* x_in = IN_F(0); const float* pre_norm = IN_F(3);
          for (int m = gw; m < M; m += NGW) { f32x4 v[16]; const GAS f32x4* xr = (const GAS f32x4*)(x_in + (size_t)m * DM) + lane;
#pragma unroll
            for (int j = 0; j < 16; ++j) v[j] = xr[64 * j];
            rms_store_i8(v, pre_norm, (bf16*)(ws + WS_H) + (size_t)m * DM, ws + WS_H8 + (size_t)m * DM, (float*)(ws + WS_SA) + m, lane); } }
    }
    GRID_BAR();

#ifndef TEST_NLAYERS
#define TEST_NLAYERS 2
#endif
    for (int l = 0; l < TEST_NLAYERS; ++l) {
        if (PH(2)) REP(2) {
            unsigned char* ws = WSP; unsigned char* wl = ws + WS_W + (size_t)l * W_LAYER;
            pg8::Gemm g{(const bf16*)(ws + WS_H), (const bf16*)(wl + W_BIG16), M, N16, DM}; pg8::StaticOrder S; S.init(M, N16, G, bx);
            pg8::EpiBig<false> E{ws, IN_F(11) + l * 16, l};
            pg8::gemm_phase<pg8::EpiBig<false>, pg8::StaticOrder, GALIGN, true, false>(lds + RING_OFF, g, S, E);
        }
        if (PH(1)) REP(1) {
            unsigned char* ws = WSP; unsigned char* wl = ws + WS_W + (size_t)l * W_LAYER;
            pg8::Gemm g{(const bf16*)(ws + WS_H8), (const bf16*)(wl + W_BIG), M, N8, DM / 2}; pg8::StaticOrder S; S.init(M, N8, G, bx);
            pg8::EpiBig<true> E{ws, IN_F(11) + l * 16, l};
            pg8::gemm_phase<pg8::EpiBig<true>, pg8::StaticOrder, GALIGN, true, true>(lds + RING_OFF, g, S, E);
        }
        GRID_BAR();
#if defined(TEST_HASHG)
        {
            PHASE_LOCALS();
#ifndef HASH_OFF
#define HASH_OFF WS_GATES
#define HASH_WORDS ((size_t)M * NMRG / 2)
#endif
            unsigned hg = 0u; const unsigned* gp = (const unsigned*)(ws + HASH_OFF);
            for (size_t i = (size_t)bx * 512 + tid; i < HASH_WORDS; i += (size_t)G * 512) hg += gp[i] * 2654435761u + (unsigned)i;
            atomicAdd((unsigned*)(ws + WS_CTL) + 2050, hg);
        }
#endif
        if (PH(3) && vcu < 128) REP(3) {
            PHASE_LOCALS();
            const int b = vcu >> 4, hh = vcu & 15; const float* lf = (const float*)(ws + WS_LOGF) + (size_t)b * SEQ * 16 + hh;
            float v0 = lf[(size_t)(4 * tid) * 16], v1 = lf[(size_t)(4 * tid + 1) * 16], v2 = lf[(size_t)(4 * tid + 2) * 16], v3 = lf[(size_t)(4 * tid + 3) * 16];
            v1 += v0; v2 += v1; v3 += v2;
            float inc = v3;
#pragma unroll
            for (int o = 1; o < 64; o <<= 1) { const float t = __shfl_up(inc, o); if (lane >= o) inc += t; }
            LAS float* wsum = (LAS float*)(lds + RING_OFF);
            if (lane == 63) wsum[wave] = inc;
            __syncthreads();
            float base = inc - v3;
            for (int w = 0; w < wave; ++w) base += wsum[w];
            float* cb = (float*)(ws + WS_CB) + ((size_t)b * 16 + hh) * SEQ + 4 * tid;
            *(f32x4*)cb = (f32x4){-(base + v0) * LOG2E_F, -(base + v1) * LOG2E_F, -(base + v2) * LOG2E_F, -(base + v3) * LOG2E_F};
            __syncthreads();
        }
        if (PH(3)) REP(3) {
            unsigned char* ws = WSP; unsigned char* wl = ws + WS_W + (size_t)l * W_LAYER;
            pg8::Gemm g{(const bf16*)(ws + WS_ACQ), (const bf16*)(wl + W_UQ), M, 3072, 1536}; pg8::StaticOrder S; S.init(M, 3072, G, bx);
            pg8::EpiQA E{ws, l};
            pg8::gemm_phase<pg8::EpiQA, pg8::StaticOrder, GALIGN, true>(lds + RING_OFF, g, S, E);
        }
        if (PH(4)) REP(4) {
            unsigned char* ws = WSP; unsigned char* wl = ws + WS_W + (size_t)l * W_LAYER;
            pg8::Gemm g{(const bf16*)(ws + WS_ACKV), (const bf16*)(wl + W_UKV), M, 4096, 512}; pg8::StaticOrder S; S.init(M, 4096, G, bx);
            pg8::EpiKV E{ws, l};
            pg8::gemm_phase<pg8::EpiKV, pg8::StaticOrder, GALIGN, true>(lds + RING_OFF, g, S, E);
        }
        GRID_BAR();
        const int cgrp = (l == 0) ? (vcu >> 1) % 3 : -1;
        if (cgrp == 0) { PHASE_LOCALS(); CONVERT_LAYER(1); }
        if (PH(5)) REP(5) { unsigned char* ws = WSP;
            att::Args TA{(const bf16*)(ws + WS_QA), (const bf16*)(ws + WS_KA), (const bf16*)(ws + WS_KR), (const bf16*)(ws + WS_VA), (const bf16*)(ws + WS_AZ), (bf16*)(ws + WS_OCAT), nullptr, nullptr, nullptr};
            for (int e = vcu * 4; e < 1024; e += ((e & 3) == 3) ? G * 4 - 3 : 1) { const int uu = e >> 1, bh = uu >> 2, pr = uu & 3;
                att::attn_unit<0>(TA, bh >> 4, bh & 15, (e & 1) ? pr : 7 - pr, lds + RING_OFF); }
        }
        if (cgrp == 1) { PHASE_LOCALS(); CONVERT_LAYER(1); }
        if (PH(6)) REP(6) { unsigned char* ws = WSP;
            att::Args TC{(const bf16*)(ws + WS_CQ), (const bf16*)(ws + WS_CK), nullptr, (const bf16*)(ws + WS_CV), (const bf16*)(ws + WS_CZ), (bf16*)(ws + WS_OCAT) + 4096, (const float*)(ws + WS_CB), nullptr, nullptr};
            for (int e = vcu * 4; e < 1024; e += ((e & 3) == 3) ? G * 4 - 3 : 1) { const int uu = e >> 1, bh = uu >> 2, pr = uu & 3;
                att::attn_unit<2>(TC, bh >> 4, bh & 15, (e & 1) ? pr : 7 - pr, lds + RING_OFF); }
        }
        if (PH(7)) REP(7) { unsigned char* ws = WSP;
            att::Args TB{(const bf16*)(ws + WS_BQ), (const bf16*)(ws + WS_BK), nullptr, (const bf16*)(ws + WS_BV), (const bf16*)(ws + WS_BZ), (bf16*)(ws + WS_OCAT) + 2048, nullptr, IN_F(2), IN_F(10) + l * 32};
            for (int u = vcu; u < 256; u += G) att::attn_unit_b(TB, u >> 5, (u >> 3) & 3, u & 7, lds + RING_OFF);
        }
        if (cgrp == 2) { PHASE_LOCALS(); CONVERT_LAYER(1); }
        GRID_BAR();
        if (PH(8)) REP(8) {
            unsigned char* ws = WSP; unsigned char* wl = ws + WS_W + (size_t)l * W_LAYER;
#if defined(P5_STAGGER)
            if (vcu & 1) { const unsigned long long t0_ = __builtin_amdgcn_s_memrealtime(); while (__builtin_amdgcn_s_memrealtime() - t0_ < (unsigned long long)(P5_STAGGER)) __builtin_amdgcn_s_sleep(32); }
#endif
            pg8::Gemm g{(const bf16*)(ws + WS_OCAT), (const bf16*)(wl + W_PROJ), M, DM, 6144}; pg8::StaticOrder S; S.init(M, DM, G, bx);
            pg8::EpiGate3 E{ws, WS_Y};
            pg8::gemm_phase<pg8::EpiGate3, pg8::StaticOrder, GALIGN, true>(lds + RING_OFF, g, S, E);
        }
        GRID_BAR();
        if (PH(9)) REP(9) {
            unsigned char* ws = WSP; unsigned char* wl = ws + WS_W + (size_t)l * W_LAYER;
            pg8::Gemm g{(const bf16*)(ws + WS_Y), (const bf16*)(wl + W_O), M, DM, DM, 1  }; pg8::StaticOrder S; S.init(M, DM, G, bx);
            pg8::EpiZ16 E{(bf16*)(ws + WS_Z), DM};
            pg8::gemm_phase<pg8::EpiZ16, pg8::StaticOrder, GALIGN, true>(lds + RING_OFF, g, S, E);
        }
        GRID_BAR();
        if (PH(10)) for (int rep_ = 0; rep_ < ((((DUP_MASK >> 10) & 1) && l == 0) ? 2 : 1); ++rep_) {
            PHASE_LOCALS();
            const float* pg = IN_F(17) + l * DM; float* xo = (float*)KARG(18); const float* x_res = l == 0 ? IN_F(0) : (const float*)xo; const float* pre1 = IN_F(3) + DM;
            for (int m = gw; m < M; m += NGW) { f32x4 v[16]; const GAS unsigned long long* zr = (const GAS unsigned long long*)(ws + WS_Z) + (size_t)(m >> 8) * 16 * 16384 + (m & 255) * 64 + lane;
                float s = 0.f;
#pragma unroll
                for (int j = 0; j < 16; ++j) { const unsigned long long zz = zr[16384 * j]; v[j].x = __uint_as_float((unsigned)zz << 16); v[j].y = __uint_as_float((unsigned)zz & 0xffff0000u); v[j].z = __uint_as_float((unsigned)(zz >> 32) << 16); v[j].w = __uint_as_float((unsigned)(zz >> 32) & 0xffff0000u);
                    s += (v[j].x * v[j].x + v[j].y * v[j].y) + (v[j].z * v[j].z + v[j].w * v[j].w); }
                const float rs = 1.0f / sqrtf(wave_sum(s) * (1.0f / DM) + 1e-6f);
                const GAS f32x4* xr = (const GAS f32x4*)(x_res + (size_t)m * DM) + lane; GAS f32x4* orow = (GAS f32x4*)(xo + (size_t)m * DM) + lane;
#pragma unroll
                for (int j = 0; j < 16; ++j) { const f32x4 gg = *((const GAS f32x4*)pg + lane + 64 * j); v[j] = xr[64 * j] + v[j] * rs * gg; orow[64 * j] = v[j]; }
                if (l == 0) rms_store_i8(v, pre1, (bf16*)(ws + WS_H) + (size_t)m * DM, ws + WS_H8 + (size_t)m * DM, (float*)(ws + WS_SA) + m, lane); }
        }
        if (l == 0) GRID_BAR();
    }
#if defined(TEST_MICRO)
    {
        PHASE_LOCALS();
        typedef int v8i_t __attribute__((ext_vector_type(8)));
        const unsigned char* A8 = ws + WS_W + W_LAYER + W_MRG8; const unsigned char* B8 = ws + WS_W + W_MRG8;
        const int r = lane & 15, kb = lane >> 4; unsigned hm = 0u;
        for (int tile = gw; tile < 512 * 16; tile += NGW) {
            const int ta = tile & 511, tb = tile >> 9;
            f32x4 accm = {0.f, 0.f, 0.f, 0.f};
            for (int kk = 0; kk < 32; ++kk) {
                const v8i_t av = *(const v8i_t*)(A8 + (size_t)(ta * 16 + r) * DM + kk * 128 + kb * 32);
                const v8i_t bv = *(const v8i_t*)(B8 + (size_t)(tb * 16 + r) * DM + kk * 128 + kb * 32);
#if TEST_MICRO == 1
                accm = __builtin_amdgcn_mfma_scale_f32_16x16x128_f8f6f4(bv, av, accm, 0, 0, 0, 0x7f7f7f7f, 0, 0x7f7f7f7f);
#else
                { const long a0 = ((long)(unsigned)av[0]) | ((long)av[1] << 32), b0 = ((long)(unsigned)bv[0]) | ((long)bv[1] << 32); accm = __builtin_amdgcn_mfma_f32_16x16x32_fp8_fp8(b0, a0, accm, 0, 0, 0); }
#endif
            }
            hm += (__float_as_uint(accm[0]) * 2654435761u) ^ (__float_as_uint(accm[1]) * 40503u) ^ (__float_as_uint(accm[2]) + __float_as_uint(accm[3]) * 7u);
        }
        atomicAdd((unsigned*)(ws + WS_CTL) + 2051, hm);
    }
#endif
#if defined(TEST_HASH)
    GRID_BAR();
    if (bx == 0 && threadIdx.x == 0) { unsigned char* ws = WSP; float* out = (float*)KARG(18);
        const unsigned a = __hip_atomic_load((unsigned*)(ws + WS_CTL) + 2048, __ATOMIC_RELAXED, __HIP_MEMORY_SCOPE_AGENT), b = __hip_atomic_load((unsigned*)(ws + WS_CTL) + 2049, __ATOMIC_RELAXED, __HIP_MEMORY_SCOPE_AGENT);
        const unsigned c = __hip_atomic_load((unsigned*)(ws + WS_CTL) + 2050, __ATOMIC_RELAXED, __HIP_MEMORY_SCOPE_AGENT); out[4] = (float)(c & 0xffffu) * 64.f; out[5] = (float)(c >> 16) * 64.f;
        { const unsigned d = __hip_atomic_load((unsigned*)(ws + WS_CTL) + 2051, __ATOMIC_RELAXED, __HIP_MEMORY_SCOPE_AGENT); out[6] = (float)(d & 0xffffu) * 64.f; out[7] = (float)(d >> 16) * 64.f; }
        out[0] = (float)(a & 0xffffu) * 64.f; out[1] = (float)(a >> 16) * 64.f; out[2] = (float)(b & 0xffffu) * 64.f; out[3] = (float)(b >> 16) * 64.f; }
#endif
#if defined(PROBE_P5)
    {
        GRID_BAR();
        unsigned char* ws = WSP; unsigned char* wl = ws + WS_W;
        pg8::Gemm g{(const bf16*)(ws + WS_OCAT), (const bf16*)(wl + W_PROJ), 3 * M, 3 * DM, 2048}; pg8::GateOrder S; S.S.init(M, DM, G, bx);
#if PROBE_P5 == 5
        pg8::EpiNull E{(float*)(ws + WS_CTL + 4096)};
        pg8::gemm_phase<pg8::EpiNull, pg8::GateOrder, true, true>(lds + RING_OFF, g, S, E);
#else
        pg8::EpiGateT<(PROBE_P5 - 1) & 3> E{ws, WS_QA};
        pg8::gemm_phase<pg8::EpiGateT<(PROBE_P5 - 1) & 3>, pg8::GateOrder, true, true>(lds + RING_OFF, g, S, E);
#endif
    }
#endif
#if defined(PROBE_ATTN)
    {
        GRID_BAR();
        unsigned char* ws = WSP;
        att::Args TC{(const bf16*)(ws + WS_CQ + 0), (const bf16*)(ws + WS_CV), nullptr, (const bf16*)(ws + WS_CV), (const bf16*)(ws + WS_CZ), (bf16*)(ws + WS_QA), (const float*)(ws + WS_CB), nullptr, nullptr};
        for (int rep = 0; rep < 2; ++rep)
        for (int e = vcu * 4; e < 1024; e += ((e & 3) == 3) ? G * 4 - 3 : 1) { const int uu = e >> 1, bh = uu >> 2, pr = uu & 3;
            att::attn_unit<2, PROBE_ATTN - 1>(TC, bh >> 4, bh & 15, (e & 1) ? pr : 7 - pr, lds + RING_OFF); }
    }
#endif
#if defined(PROBE_GEMM)
    {
        GRID_BAR();
        unsigned char* ws = WSP; unsigned char* wl = ws + WS_W;
        pg8::Gemm g{(const bf16*)(ws + WS_H), (const bf16*)(wl + W_BIG), M, NBIG, DM};
#if PROBE_GEMM == 1
        pg8::FixedOrder S{29, 0, 0, 0, 0};
#elif PROBE_GEMM == 2
        pg8::FixedOrder S{29, (int)(blockIdx.x & 63), (int)(blockIdx.x >> 6) * 29, 0, 1};
#else
        pg8::StaticOrder S; S.init(M, NBIG, G, bx);
#endif
#if PROBE_GEMM == 4
        pg8::EpiBig E{ws, IN_F(11), 2};
        pg8::gemm_phase<pg8::EpiBig, decltype(S), true, true>(lds + RING_OFF, g, S, E);
#else
        pg8::EpiNull E{(float*)(ws + WS_CTL + 4096)};
        pg8::gemm_phase<pg8::EpiNull, decltype(S), true, true>(lds + RING_OFF, g, S, E);
#endif
    }
#endif
}

extern "C" void kernel_launch(void* const* d_in, const int* in_sizes, int n_in, void* d_out, int out_size, void* d_ws, size_t ws_size, hipStream_t stream) {
    static int grid = 0;
    if (grid == 0) {
        if (n_in != 18 || out_size != M * DM || ws_size < WS_END) { fprintf(stderr, "kernel_launch: unexpected shapes (n_in %d out %d ws %zu)\n", n_in, out_size, ws_size); grid = -1; return; }
        int dev = 0, cus = 0, per_cu = 0;
        if (hipGetDevice(&dev) != hipSuccess || hipDeviceGetAttribute(&cus, hipDeviceAttributeMultiprocessorCount, dev) != hipSuccess) { grid = -1; return; }
        if (hipFuncSetAttribute((const void*)mk_fwd, hipFuncAttributeMaxDynamicSharedMemorySize, LDS_BYTES) != hipSuccess) { fprintf(stderr, "kernel_launch: hipFuncSetAttribute failed\n"); grid = -1; return; }
        if (hipOccupancyMaxActiveBlocksPerMultiprocessor(&per_cu, (const void*)mk_fwd, NWAVES * 64, LDS_BYTES) != hipSuccess || per_cu < 1)
            fprintf(stderr, "kernel_launch: note: occupancy query reports %d workgroups per CU\n", per_cu);
        (void)hipGetLastError();
        grid = cus;
    }
    if (grid < 0) return;
    if (hipMemsetAsync((char*)d_ws + WS_CTL, 0, CTL_ZERO_BYTES, stream) != hipSuccess) return;
    Args a{};
    for (int i = 0; i < 18; ++i) a.in[i] = d_in[i];
    a.out = (float*)d_out; a.ws = (unsigned char*)d_ws;
    hipLaunchKernelGGL(mk_fwd, dim3(grid), dim3(NWAVES * 64), LDS_BYTES, stream, a);
}
```

```cpp
#include <hip/hip_runtime.h>
#include <cstdio>
#include <cstdint>
#include <cmath>
#ifndef GALIGN
#define GALIGN true
#endif
#ifndef P2B_ALIGN
#define P2B_ALIGN true
#endif
#ifndef P2B_SP2
#define P2B_SP2 true
#endif
#ifndef GATE_DESCALE
#define GATE_DESCALE 0.015625f
#endif
#ifndef TEST_ASM_BF16
#define TEST_ASM_BF16 false
#endif
#ifndef TEST_FP8_FLAG
#define TEST_FP8_FLAG true
#endif
constexpr int NWAVES = 8;
constexpr int M_ROWS = 16384, NBIG_COLS = 26368;
constexpr int M = 16384, DM = 4096, SEQ = 2048, NBATCH = 8, NBIG = 29440, N8 = 26368  , N16 = 3072  , NIN = 16976, NMRG = 12288;
constexpr float LOG2E_F = 1.4426950408889634f;
constexpr float QS_A = 0.07216878364870323f * LOG2E_F;
constexpr float QS_B = 0.125f * LOG2E_F;
constexpr float QS_C = 0.08838834764831845f * LOG2E_F;
constexpr size_t MiB = 1u << 20;
constexpr size_t WS_CTL = 0, CTL_ZERO_BYTES = 1 * MiB;
constexpr size_t WS_W = 2 * MiB, W_LAYER = 323 * MiB, W_BIG = 0  , W_BIG16 = 104 * MiB  , W_UQ = 230 * MiB, W_UKV = 239 * MiB, W_PROJ = 243 * MiB, W_O = 291 * MiB;
constexpr size_t WS_H = 648 * MiB, WS_ACQ = 776 * MiB, WS_ACKV = 824 * MiB, WS_QA = 840 * MiB, WS_KA = 936 * MiB, WS_VA = 1000 * MiB, WS_AZ = 1064 * MiB,
                 WS_CQ = 1128 * MiB, WS_CK = 1192 * MiB, WS_CV = 1256 * MiB, WS_CZ = 1320 * MiB, WS_BQ = 1384 * MiB, WS_BZ = 1448 * MiB, WS_BK = 1512 * MiB, WS_BV = 1520 * MiB,
                 WS_KR = 1528 * MiB, WS_LOGF = 1530 * MiB, WS_CB = 1531 * MiB, WS_RS = 1532 * MiB, WS_ROPEC = 1533 * MiB, WS_ROPES = 1535 * MiB, WS_GATES = 1538 * MiB,
                 WS_OCAT = WS_H, WS_YACC = WS_QA, WS_Y = WS_CQ, WS_Z = WS_GATES, WS_H8 = 1922 * MiB  , WS_END = 1986 * MiB;
constexpr size_t WS_SA = WS_RS + 512 * 1024  , WS_SB = WS_RS + 576 * 1024  , WS_CMAX = WS_CTL + 65536  ;
constexpr int CW_TMO = 0, CW_BAR = 4096;
constexpr int RING_OFF = 0, RING_BYTES = 131072, LDS_BYTES = 147456, LDSCTL_OFF = LDS_BYTES - 1024  , MISC_OFF = LDSCTL_OFF + 320;
namespace pg8 {
#define PG8_LAS __attribute__((address_space(3)))
typedef unsigned short bf16_t;
typedef short bf16x8 __attribute__((ext_vector_type(8)));
typedef float f32x4 __attribute__((ext_vector_type(4)));
typedef unsigned u32x4 __attribute__((ext_vector_type(4)));
constexpr int BM = 256, BK = 64, HALF = 128, HTB = HALF * BK * 2  , STAGE_BYTES = 8 * HTB, NXCD = 8, WGM = 8;

__host__ __device__ __forceinline__ int lds_byte(int r, int c) { const int st = (r >> 4) * 2 + (c >> 5), rr = r & 15, cc = c & 31, ob = rr * 64 + cc * 2; return st * 1024 + (ob ^ (((ob >> 9) & 1) << 5)); }
__host__ __device__ __forceinline__ void stage_rc(int b, int& R, int& C) { const int st = b / 1024, sb = b % 1024, swz = sb ^ (((sb >> 9) & 1) << 5); R = (st >> 1) * 16 + swz / 64; C = (st & 1) * 32 + (swz % 64) / 2; }
__host__ __device__ __forceinline__ int perm32(int rho) { const int n = rho >> 4, i = rho & 15; return 8 * (i >> 2) + 4 * n + (i & 3); }

struct Unit { int pm, pn; };
struct Gemm { const bf16_t* A; const bf16_t* Bt; int M, N, K; int aktm; };

struct StaticOrder {
    int nM, nN, nwg, G, c;
    __host__ __device__ void init(int M, int N, int G_, int c_) { nM = M / BM; nN = N / BM; nwg = nM * nN; G = G_; c = c_; }
    __host__ __device__ bool next(int i, Unit& u) const {
        const long L = (long)i * G + c; if (L >= nwg) return false;
        int wgid = (int)L; { const int q = nwg / NXCD, r = nwg % NXCD, xcd = wgid % NXCD, off = wgid / NXCD; wgid = (xcd < r ? xcd * (q + 1) : r * (q + 1) + (xcd - r) * q) + off; }
        const int nig = WGM * nN, gid = wgid / nig, fm = gid * WGM, gsz = (nM - fm) < WGM ? (nM - fm) : WGM;
        u.pm = fm + ((wgid % nig) % gsz); u.pn = (wgid % nig) / gsz; return true;
    }
    __device__ __forceinline__ void a_ready(const Unit&) const {}
    __device__ __forceinline__ void done(const Unit&) const {}
};

typedef float pg8_f32x2 __attribute__((ext_vector_type(2))); typedef __bf16 pg8_bf16x2 __attribute__((ext_vector_type(2)));
__device__ __forceinline__ unsigned cvt_pk_bf16(float lo, float hi) { const pg8_f32x2 v = {lo, hi}; const pg8_bf16x2 b = __builtin_convertvector(v, pg8_bf16x2); return __builtin_bit_cast(unsigned, b); }
__device__ __forceinline__ float bf_lo(unsigned w) { return __uint_as_float(w << 16); }
__device__ __forceinline__ float bf_hi(unsigned w) { return __uint_as_float(w & 0xffff0000u); }
__device__ __forceinline__ float sigmoidf_(float v) { return __builtin_amdgcn_rcpf(1.0f + __builtin_amdgcn_exp2f(-1.4426950408889634f * v)); }
__device__ __forceinline__ u32x4 pack8(f32x4 a, f32x4 b) { u32x4 w; w.x = cvt_pk_bf16(a[0], a[1]); w.y = cvt_pk_bf16(a[2], a[3]); w.z = cvt_pk_bf16(b[0], b[1]); w.w = cvt_pk_bf16(b[2], b[3]); return w; }

__device__ __forceinline__ size_t gate_slot(int tile, int ai, int m, int bj, int wave, int lane) { return (size_t)tile * 8192 + (size_t)((((ai * 4 + m) * 2 + bj) * 8 + wave) * 64 + lane); }
__device__ __forceinline__ size_t gate_slot8(int tile, int ai, int m, int wave, int lane) { return (size_t)tile * 4096 + (size_t)(((ai * 4 + m) * 8 + wave) * 64 + lane); }
__device__ __forceinline__ unsigned pk_u8x4(f32x4 g) { unsigned w = 0u;
#pragma unroll
    for (int e = 0; e < 4; ++e) { unsigned q = (unsigned)(int)(g[e] * 255.0f + 0.5f); q = q < 1u ? 1u : q; w |= q << (8 * e); }
    return w; }
__device__ __forceinline__ float u8f(unsigned w, int k) { return (float)((w >> (8 * k)) & 0xffu); }
template <bool I8> struct EpiBig {
    static constexpr bool PERM = true, AFTER_DRAIN = false, ASM_MMA = false, MIDK = false;
    unsigned char* ws;
    const float* bfp;
    int layer;
    __device__ __forceinline__ void operator()(const f32x4 (&acc)[2][2][4][2], const Unit& u, int wr, int wc, int fr_in, int fq_in) const {
        int fr = fr_in, fq = fq_in; asm volatile("" : "+v"(fr), "+v"(fq));
        unsigned long long* rsq = (unsigned long long*)(ws + WS_RS) + (size_t)layer * 2 * M_ROWS; unsigned long long* rskv = rsq + M_ROWS;
        const float* ropeC = (const float*)(ws + WS_ROPEC); const float* ropeS = (const float*)(ws + WS_ROPES);
        const int pn = u.pn;
        const int row0 = u.pm * BM + wr * 64 + fr;
        const int lc0 = wc * 32 + 8 * fq;
        const float* SA = (const float*)(ws + WS_SA);
        f32x4 sbv[2][2];
        if constexpr (I8) { const float* SBp = (const float*)(ws + WS_SB) + (size_t)layer * NBIG_COLS + pn * BM + lc0;
#pragma unroll
            for (int bj = 0; bj < 2; ++bj) { sbv[bj][0] = *(const f32x4*)(SBp + bj * HALF); sbv[bj][1] = *(const f32x4*)(SBp + bj * HALF + 4); } }
#define DEQ(ai_, bj_, m_, n_, sa_) ({ f32x4 t_; if constexpr (I8) { _Pragma("unroll") for (int e_ = 0; e_ < 4; ++e_) t_[e_] = (float)__float_as_int(acc[ai_][bj_][m_][n_][e_]) * (sa_) * sbv[bj_][n_][e_]; } else t_ = acc[ai_][bj_][m_][n_]; t_; })
        if (!I8 && pn == 11) {
            if (lc0 < 64) {
                const int i0 = (lc0 >> 3) * 4;
#pragma unroll
                for (int ai = 0; ai < 2; ++ai)
#pragma unroll
                    for (int m = 0; m < 4; ++m) { const int row = row0 + ai * HALF + m * 16;
                        const f32x4 c = *(const f32x4*)(ropeC + (size_t)row * 32 + i0), s = *(const f32x4*)(ropeS + (size_t)row * 32 + i0);
                        const f32x4 x1 = acc[ai][0][m][0], x2 = acc[ai][0][m][1];
                        const f32x4 o1 = x1 * c - x2 * s, o2 = x2 * c + x1 * s;
                        *(u32x4*)((bf16_t*)(ws + WS_KR) + (size_t)row * 64 + lc0) = pack8(o1, o2); }
            } else if (lc0 < 80) {
                const int h0 = lc0 - 64;
                const f32x4 b0 = *(const f32x4*)(bfp + h0), b1 = *(const f32x4*)(bfp + h0 + 4);
#pragma unroll
                for (int ai = 0; ai < 2; ++ai)
#pragma unroll
                    for (int m = 0; m < 4; ++m) { const int row = row0 + ai * HALF + m * 16;
                        f32x4 v0 = acc[ai][0][m][0] + b0, v1 = acc[ai][0][m][1] + b1;
#pragma unroll
                        for (int e = 0; e < 4; ++e) { v0[e] = fminf(v0[e], 0.f) - __logf(1.0f + __expf(-fabsf(v0[e]))); v1[e] = fminf(v1[e], 0.f) - __logf(1.0f + __expf(-fabsf(v1[e]))); }
                        float* lp = (float*)(ws + WS_LOGF) + (size_t)row * 16 + h0;
                        *(f32x4*)lp = v0; *(f32x4*)(lp + 4) = v1; }
            }
            return;
        }
        size_t off; int ldc, colt; float sc = 1.f; int mode = 0;
        if constexpr (I8) {
            if (pn < 6)       { off = WS_ACQ;  ldc = 1536; colt = pn * 256; mode = 2; }
            else if (pn < 14) { off = WS_BQ;   ldc = 2048; colt = (pn - 6) * 256; sc = QS_B; }
            else if (pn < 15) { off = WS_BK;   ldc = 256;  colt = 0; }
            else if (pn < 23) { off = WS_CQ;   ldc = 2048; colt = (pn - 15) * 256; sc = QS_C; }
            else if (pn < 31) { off = WS_CK;   ldc = 2048; colt = (pn - 23) * 256; }
            else if (pn < 39) { off = WS_BZ;   ldc = 2048; colt = (pn - 31) * 256; }
            else if (pn < 47) { off = WS_AZ;   ldc = 2048; colt = (pn - 39) * 256; }
            else if (pn < 55) { off = WS_CZ;   ldc = 2048; colt = (pn - 47) * 256; }
            else              { off = WS_GATES; ldc = 12288; colt = (pn - 55) * 256; mode = 1; }
        } else {
            if (pn < 2)       { off = WS_ACKV; ldc = 512;  colt = pn * 256; mode = 3; }
            else if (pn < 3)  { off = WS_BV;   ldc = 256;  colt = 0; }
            else              { off = WS_CV;   ldc = 2048; colt = (pn - 3) * 256; }
        }
        bf16_t* base = (bf16_t*)(ws + off);
        const int col0 = colt + lc0;
        float sav[2][4];
#pragma unroll
        for (int ai = 0; ai < 2; ++ai)
#pragma unroll
            for (int m = 0; m < 4; ++m) { sav[ai][m] = 1.f; if constexpr (I8) sav[ai][m] = SA[row0 + ai * HALF + m * 16]; }
        asm volatile("" ::: "memory");
#pragma unroll
        for (int ai = 0; ai < 2; ++ai)
#pragma unroll
            for (int m = 0; m < 4; ++m) { const int row = row0 + ai * HALF + m * 16; bf16_t* rowp = base + (size_t)row * ldc + col0; const float sa = sav[ai][m];
                float ss = 0.f; u32x4 gw8 = {0u, 0u, 0u, 0u};
#pragma unroll
                for (int bj = 0; bj < 2; ++bj) { f32x4 v0 = DEQ(ai, bj, m, 0, sa), v1 = DEQ(ai, bj, m, 1, sa);
                    if (mode >= 2) ss += (v0[0] * v0[0] + v0[1] * v0[1]) + (v0[2] * v0[2] + v0[3] * v0[3]) + (v1[0] * v1[0] + v1[1] * v1[1]) + (v1[2] * v1[2] + v1[3] * v1[3]);
                    if (mode == 1) {
#pragma unroll
                        for (int e = 0; e < 4; ++e) { v0[e] = sigmoidf_(v0[e]); v1[e] = sigmoidf_(v1[e]); } }
                    else { v0 = v0 * sc; v1 = v1 * sc; }
                    if (mode == 1) { gw8[2 * bj] = pk_u8x4(v0); gw8[2 * bj + 1] = pk_u8x4(v1); }
                    else *(u32x4*)(rowp + bj * HALF) = pack8(v0, v1); }
                if (mode == 1) *((u32x4*)(ws + WS_GATES) + gate_slot8(u.pm * 48 + (pn - 55), ai, m, wr * 4 + wc, fq * 16 + fr)) = gw8;
                if (mode >= 2) { ss += __shfl_xor(ss, 16); ss += __shfl_xor(ss, 32);
                    if (fq == 0) atomicAdd((mode == 2 ? rsq : rskv) + row, (unsigned long long)(ss * 4294967296.0f)); } }
#undef DEQ
    }
};

struct EpiQA {
    static constexpr bool PERM = true, AFTER_DRAIN = false, ASM_MMA = false, MIDK = false;
    unsigned char* ws; int layer;
    __device__ __forceinline__ void operator()(const f32x4 (&acc)[2][2][4][2], const Unit& u, int wr, int wc, int fr_in, int fq_in) const {
        int fr = fr_in, fq = fq_in; asm volatile("" : "+v"(fr), "+v"(fq));
        bf16_t* O = (bf16_t*)(ws + WS_QA); const unsigned long long* rsq = (const unsigned long long*)(ws + WS_RS) + (size_t)layer * 2 * M_ROWS;
        const float* ropeC = (const float*)(ws + WS_ROPEC); const float* ropeS = (const float*)(ws + WS_ROPES); constexpr float qs = QS_A;
        const int row0 = u.pm * BM + wr * 64 + fr;
        const int colb = u.pn * BM + wc * 32 + 8 * fq;
        unsigned long long rq[2][4];
#pragma unroll
        for (int ai = 0; ai < 2; ++ai)
#pragma unroll
            for (int m = 0; m < 4; ++m) rq[ai][m] = rsq[row0 + ai * HALF + m * 16];
        const int cm0 = colb % 192, cm1 = (colb + HALF) % 192;
#pragma unroll
        for (int q = 0; q < 4; ++q) {
            f32x4 cv[2][2], sv[2][2];
#pragma unroll
            for (int mm = 0; mm < 2; ++mm) { const int row = row0 + (q >> 1) * HALF + ((q & 1) * 2 + mm) * 16;
                if (cm0 >= 128) { const int i0 = ((cm0 - 128) >> 3) * 4; cv[mm][0] = *(const f32x4*)(ropeC + (size_t)row * 32 + i0); sv[mm][0] = *(const f32x4*)(ropeS + (size_t)row * 32 + i0); }
                if (cm1 >= 128) { const int i0 = ((cm1 - 128) >> 3) * 4; cv[mm][1] = *(const f32x4*)(ropeC + (size_t)row * 32 + i0); sv[mm][1] = *(const f32x4*)(ropeS + (size_t)row * 32 + i0); } }
            asm volatile("" ::: "memory");
#pragma unroll
            for (int mm = 0; mm < 2; ++mm) { const int ai = q >> 1, m = (q & 1) * 2 + mm; const int row = row0 + ai * HALF + m * 16;
                const float rs = __builtin_amdgcn_rsqf((float)rq[ai][m] * (2.3283064365386963e-10f / 1536.0f) + 1e-6f) * qs;
#pragma unroll
                for (int bj = 0; bj < 2; ++bj) { const int col = colb + bj * HALF; const int cm = bj ? cm1 : cm0;
                    f32x4 v0 = acc[ai][bj][m][0] * rs, v1 = acc[ai][bj][m][1] * rs;
                    if (cm >= 128) { const f32x4 c = cv[mm][bj], s = sv[mm][bj]; const f32x4 o1 = v0 * c - v1 * s, o2 = v1 * c + v0 * s; v0 = o1; v1 = o2; }
                    *(u32x4*)(O + (size_t)row * 3072 + col) = pack8(v0, v1); } }
        }
    }
};

struct EpiKV {
    static constexpr bool PERM = true, AFTER_DRAIN = false, ASM_MMA = false, MIDK = false;
    unsigned char* ws; int layer;
    __device__ __forceinline__ void operator()(const f32x4 (&acc)[2][2][4][2], const Unit& u, int wr, int wc, int fr_in, int fq_in) const {
        int fr = fr_in, fq = fq_in; asm volatile("" : "+v"(fr), "+v"(fq));
        const unsigned long long* rskv = (const unsigned long long*)(ws + WS_RS) + (size_t)layer * 2 * M_ROWS + M_ROWS;
        const int row0 = u.pm * BM + wr * 64 + fr;
        bf16_t* base = (bf16_t*)(ws + (u.pn < 8 ? WS_KA : WS_VA));
        const int col0 = (u.pn & 7) * BM + wc * 32 + 8 * fq;
        unsigned long long rq[2][4];
#pragma unroll
        for (int ai = 0; ai < 2; ++ai)
#pragma unroll
            for (int m = 0; m < 4; ++m) rq[ai][m] = rskv[row0 + ai * HALF + m * 16];
        asm volatile("" ::: "memory");
#pragma unroll
        for (int ai = 0; ai < 2; ++ai)
#pragma unroll
            for (int m = 0; m < 4; ++m) { const int row = row0 + ai * HALF + m * 16;
                const float rs = __builtin_amdgcn_rsqf((float)rq[ai][m] * (2.3283064365386963e-10f / 512.0f) + 1e-6f);
#pragma unroll
                for (int bj = 0; bj < 2; ++bj)
                    *(u32x4*)(base + (size_t)row * 2048 + col0 + bj * HALF) = pack8(acc[ai][bj][m][0] * rs, acc[ai][bj][m][1] * rs); }
    }
};

template <int GVAR = 0> struct EpiGateT {
    static constexpr bool PERM = true, AFTER_DRAIN = false, ASM_MMA = false, MIDK = false;
    unsigned char* ws; size_t yoff;
    __device__ __forceinline__ void operator()(const f32x4 (&acc)[2][2][4][2], const Unit& u, int wr, int wc, int fr_in, int fq_in) const {
        int fr = fr_in, fq = fq_in; asm volatile("" : "+v"(fr), "+v"(fq));
        const bf16_t* gates = (const bf16_t*)(ws + WS_GATES); bf16_t* Y = (bf16_t*)(ws + yoff);
        const int br = u.pm >> 6, pm = u.pm & 63, pn = u.pn & 15;
        const int row0 = pm * BM + wr * 64 + fr, col0 = pn * BM + wc * 32 + 8 * fq;
#pragma unroll
        for (int q = 0; q < 4; ++q) {
            u32x4 gv[2][2], yv[2][2];
#pragma unroll
            for (int mm = 0; mm < 2; ++mm)
#pragma unroll
                for (int bj = 0; bj < 2; ++bj) { const int row = row0 + (q >> 1) * HALF + ((q & 1) * 2 + mm) * 16;
                    if constexpr (GVAR & 2) gv[mm][bj] = (u32x4){0x3f003f00u, 0x3f003f00u, 0x3f003f00u, 0x3f003f00u}; else gv[mm][bj] = *(const u32x4*)(gates + (size_t)row * 12288 + br * 4096 + col0 + bj * HALF);
                    if (!(GVAR & 1) && br > 0) yv[mm][bj] = *(const u32x4*)(Y + (size_t)row * 4096 + col0 + bj * HALF); }
            asm volatile("" ::: "memory");
#pragma unroll
            for (int mm = 0; mm < 2; ++mm) { const int ai = q >> 1, m = (q & 1) * 2 + mm; const int row = row0 + ai * HALF + m * 16;
#pragma unroll
                for (int bj = 0; bj < 2; ++bj) { const int col = col0 + bj * HALF; const u32x4 g = gv[mm][bj];
                    f32x4 v0 = acc[ai][bj][m][0], v1 = acc[ai][bj][m][1];
                    v0[0] *= bf_lo(g.x); v0[1] *= bf_hi(g.x); v0[2] *= bf_lo(g.y); v0[3] *= bf_hi(g.y);
                    v1[0] *= bf_lo(g.z); v1[1] *= bf_hi(g.z); v1[2] *= bf_lo(g.w); v1[3] *= bf_hi(g.w);
                    if (!(GVAR & 1) && br > 0) { const u32x4 y = yv[mm][bj]; v0[0] += bf_lo(y.x); v0[1] += bf_hi(y.x); v0[2] += bf_lo(y.y); v0[3] += bf_hi(y.y); v1[0] += bf_lo(y.z); v1[1] += bf_hi(y.z); v1[2] += bf_lo(y.w); v1[3] += bf_hi(y.w); }
                    *(u32x4*)(Y + (size_t)row * 4096 + col) = pack8(v0, v1); } }
            asm volatile("" ::: "memory");
        }
    }
};
typedef EpiGateT<0> EpiGate;
struct GateOrder {
    StaticOrder S;
    __device__ __forceinline__ bool next(int i, Unit& u) const { const int t = i / 3, br = i - 3 * t; Unit v; if (!S.next(t, v)) return false; u.pm = br * 64 + v.pm; u.pn = br * 16 + v.pn; return true; }
    __device__ __forceinline__ void a_ready(const Unit&) const {}
    __device__ __forceinline__ void done(const Unit&) const {}
};

struct EpiGate3 {
    static constexpr bool PERM = true, AFTER_DRAIN = false, ASM_MMA = false, MIDK = true;
    static constexpr int MID0 = 32, MID1 = 64;
    unsigned char* ws; size_t yoff;
    __device__ __forceinline__ void mid(f32x4 (&acc)[2][2][4][2], const Unit& u, int wr, int wc, int fr_in, int fq_in, int step) const {
        int fr = fr_in, fq = fq_in; asm volatile("" : "+v"(fr), "+v"(fq));
        const u32x4* gbase = (const u32x4*)(ws + WS_GATES); const int tnum = u.pm * 48 + step * 16 + u.pn, tden = tnum + 16, wv = wr * 4 + wc, ln = fq * 16 + fr;
        u32x4 gn[2][2], gd[2][2];
#define G3_LOAD(q_, s_) do { _Pragma("unroll") for (int mm = 0; mm < 2; ++mm) { \
            gn[s_][mm] = gbase[gate_slot8(tnum, (q_) >> 1, ((q_) & 1) * 2 + mm, wv, ln)]; gd[s_][mm] = gbase[gate_slot8(tden, (q_) >> 1, ((q_) & 1) * 2 + mm, wv, ln)]; } } while (0)
        G3_LOAD(0, 0);
#pragma unroll
        for (int q = 0; q < 4; ++q) {
            if (q < 3) G3_LOAD(q + 1, (q + 1) & 1);
            asm volatile("" ::: "memory");
#pragma unroll
            for (int mm = 0; mm < 2; ++mm) { const int ai = q >> 1, m = (q & 1) * 2 + mm; const u32x4 n = gn[q & 1][mm], d = gd[q & 1][mm]; const unsigned nw[4] = {n.x, n.y, n.z, n.w}, dw[4] = {d.x, d.y, d.z, d.w};
#pragma unroll
                for (int bj = 0; bj < 2; ++bj)
#pragma unroll
                    for (int nn = 0; nn < 2; ++nn)
#pragma unroll
                        for (int k = 0; k < 4; ++k) acc[ai][bj][m][nn][k] *= u8f(nw[2 * bj + nn], k) * __builtin_amdgcn_rcpf(u8f(dw[2 * bj + nn], k));
            }
        }
#undef G3_LOAD
    }
    __device__ __forceinline__ void operator()(const f32x4 (&acc)[2][2][4][2], const Unit& u, int wr, int wc, int fr_in, int fq_in) const {
        int fr = fr_in, fq = fq_in; asm volatile("" : "+v"(fr), "+v"(fq));
        const u32x4* gbase = (const u32x4*)(ws + WS_GATES); const int tg = u.pm * 48 + 2 * 16 + u.pn, wv = wr * 4 + wc, ln = fq * 16 + fr; bf16_t* Y = (bf16_t*)(ws + yoff);
        const int row0 = u.pm * BM + wr * 64 + fr;
        u32x4 gv[4][2];
#pragma unroll
        for (int q = 0; q < 4; ++q)
#pragma unroll
            for (int mm = 0; mm < 2; ++mm) gv[q][mm] = gbase[gate_slot8(tg, q >> 1, (q & 1) * 2 + mm, wv, ln)];
        asm volatile("" ::: "memory");
#pragma unroll
        for (int q = 0; q < 4; ++q) {
#pragma unroll
            for (int mm = 0; mm < 2; ++mm) { const int ai = q >> 1, m = (q & 1) * 2 + mm; const int row = row0 + ai * HALF + m * 16; const u32x4 g = gv[q][mm]; const unsigned gw[4] = {g.x, g.y, g.z, g.w};
#pragma unroll
                for (int bj = 0; bj < 2; ++bj) { f32x4 v0 = acc[ai][bj][m][0], v1 = acc[ai][bj][m][1];
#pragma unroll
                    for (int k = 0; k < 4; ++k) { v0[k] *= u8f(gw[2 * bj], k) * (1.0f / 255.0f); v1[k] *= u8f(gw[2 * bj + 1], k) * (1.0f / 255.0f); }
                    *(u32x4*)(Y + ((size_t)((u.pm * 64 + u.pn * 4 + bj * 2 + (wc >> 1)) * 256) + (row - u.pm * BM)) * 64 + (wc & 1) * 32 + 8 * fq) = pack8(v0, v1); } }
        }
    }
};

struct EpiZ16 {
    static constexpr bool PERM = true, AFTER_DRAIN = false, ASM_MMA = false, MIDK = false;
    bf16_t* O; int ldc;
    __device__ __forceinline__ void operator()(const f32x4 (&acc)[2][2][4][2], const Unit& u, int wr, int wc, int fr_in, int fq_in) const {
        int fr = fr_in, fq = fq_in; asm volatile("" : "+v"(fr), "+v"(fq));
        const int row0 = u.pm * BM + wr * 64 + fr, col0 = u.pn * BM + wc * 32 + 8 * fq;
#pragma unroll
        for (int ai = 0; ai < 2; ++ai)
#pragma unroll
            for (int m = 0; m < 4; ++m) { bf16_t* rowp = O + (size_t)(u.pm * 16 + u.pn) * 65536 + (size_t)(wr * 64 + fr + ai * HALF + m * 16) * 256 + wc * 32 + 8 * fq;
#pragma unroll
                for (int bj = 0; bj < 2; ++bj) *(u32x4*)(rowp + bj * HALF) = pack8(acc[ai][bj][m][0], acc[ai][bj][m][1]); }
    }
};

struct EpiNull {
    static constexpr bool PERM = true, AFTER_DRAIN = false, ASM_MMA = false, MIDK = false;
    float* sink;
    __device__ __forceinline__ void operator()(const f32x4 (&acc)[2][2][4][2], const Unit& u, int wr, int wc, int fr_in, int fq_in) const {
        int fr = fr_in, fq = fq_in; asm volatile("" : "+v"(fr), "+v"(fq));
        float s = 0.f;
#pragma unroll
        for (int ai = 0; ai < 2; ++ai)
#pragma unroll
            for (int bj = 0; bj < 2; ++bj)
#pragma unroll
                for (int m = 0; m < 4; ++m)
#pragma unroll
                    for (int n = 0; n < 2; ++n) s += acc[ai][bj][m][n][0] + acc[ai][bj][m][n][1] + acc[ai][bj][m][n][2] + acc[ai][bj][m][n][3];
        if (s == 1.2345678e33f) sink[0] = s;
    }
};
struct FixedOrder {
    int n, pm0, pn0, dpm, dpn;
    __device__ __forceinline__ bool next(int i, Unit& u) const { if (i >= n) return false; u.pm = pm0 + i * dpm; u.pn = pn0 + i * dpn; return true; }
    __device__ __forceinline__ void a_ready(const Unit&) const {}
    __device__ __forceinline__ void done(const Unit&) const {}
};
template <class Epi, class Sched, bool ALIGN_EPI = false, bool SP2 = false, bool FP8 = false>
__device__ __forceinline__ void gemm_phase(PG8_LAS unsigned char* lds, const Gemm g, const Sched& S, const Epi& E) {
    int tid_l = threadIdx.x; asm volatile("" : "+v"(tid_l));
    const int tid = tid_l, wid = __builtin_amdgcn_readfirstlane(tid >> 6), lane = tid & 63, wr = wid >> 2, wc = wid & 3, fr = lane & 15, fq = lane >> 4;
    const int K = g.K, nt = K / BK;
    unsigned voffA[2], voffB[2];
#pragma unroll
    for (int i = 0; i < 2; ++i) { int R, C; stage_rc(tid * 16 + i * 8192, R, C); const int Rb = Epi::PERM ? ((R & ~31) + perm32(R & 31)) : R;
        voffA[i] = (unsigned)(R * (g.aktm ? BK : K) + C) * 2u; voffB[i] = (unsigned)(Rb * K + C) * 2u; }
    const size_t kstep = (size_t)(BK * 2);
    const size_t hstep = (size_t)HALF * K * 2;
    const size_t tstep = 2 * hstep;
    const size_t kstepA = g.aktm ? (size_t)(BM * BK * 2) : kstep, hstepA = g.aktm ? (size_t)(HALF * BK * 2) : hstep, tstepA = g.aktm ? (size_t)nt * (BM * BK * 2) : tstep;
    const unsigned ldsw = (unsigned)wid * 1024u;
    const int aoff = lds_byte(wr * 64 + fr, fq * 8), boff = lds_byte(wc * 32 + fr, fq * 8);
#define PG8_SA(b, h) (((b) * 2 + (h)) * HTB)
#define PG8_SB(b, h) ((4 + (b) * 2 + (h)) * HTB)
#define PG8_STAGE(bufoff, gbase, voff) do { _Pragma("unroll") for (int _i = 0; _i < 2; ++_i) \
        __builtin_amdgcn_global_load_lds((const unsigned*)((const char*)(gbase) + (voff)[_i]), (PG8_LAS unsigned*)(lds + (bufoff) + ldsw + _i * 8192), 16, 0, 0); } while (0)
typedef int pg8_v8i __attribute__((ext_vector_type(8))); typedef int pg8_v2i __attribute__((ext_vector_type(2))); typedef int pg8_v4i __attribute__((ext_vector_type(4)));
#define PG8_CAT(x, y) __builtin_shufflevector(__builtin_bit_cast(pg8_v4i, x), __builtin_bit_cast(pg8_v4i, y), 0, 1, 2, 3, 4, 5, 6, 7)
#define PG8_LDA(dst, b, h) do { _Pragma("unroll") for (int m = 0; m < 4; ++m) _Pragma("unroll") for (int k = 0; k < 2; ++k) dst[m][k] = *(const PG8_LAS bf16x8*)(lds + PG8_SA(b, h) + aoff + m * 2048 + k * 1024); } while (0)
#define PG8_LDB(dst, b, h) do { _Pragma("unroll") for (int n = 0; n < 2; ++n) _Pragma("unroll") for (int k = 0; k < 2; ++k) dst[n][k] = *(const PG8_LAS bf16x8*)(lds + PG8_SB(b, h) + boff + n * 2048 + k * 1024); } while (0)
#define PG8_MMA(ai, bj, At, Bt) do { __builtin_amdgcn_s_setprio(1); \
        if constexpr (FP8) { _Pragma("unroll") for (int m = 0; m < 4; ++m) _Pragma("unroll") for (int n = 0; n < 2; ++n) _Pragma("unroll") for (int k = 0; k < 2; ++k) \
            acc[ai][bj][m][n] = __builtin_bit_cast(f32x4, __builtin_amdgcn_mfma_i32_16x16x64_i8(__builtin_bit_cast(pg8_v4i, Bt[n][k]), __builtin_bit_cast(pg8_v4i, At[m][k]), __builtin_bit_cast(pg8_v4i, acc[ai][bj][m][n]), 0, 0, 0)); } \
        else { _Pragma("unroll") for (int m = 0; m < 4; ++m) _Pragma("unroll") for (int n = 0; n < 2; ++n) _Pragma("unroll") for (int k = 0; k < 2; ++k) \
            acc[ai][bj][m][n] = __builtin_amdgcn_mfma_f32_16x16x32_bf16(Bt[n][k], At[m][k], acc[ai][bj][m][n], 0, 0, 0); } \
        __builtin_amdgcn_s_setprio(0); } while (0)
#define PG8_WAIT_V(n) asm volatile("s_waitcnt vmcnt(" #n ")" ::: "memory")
#define PG8_WAIT_L(n) asm volatile("s_waitcnt lgkmcnt(" #n ")" ::: "memory")
#define PG8_BAR __builtin_amdgcn_s_barrier()
#define PG8_SCHED __builtin_amdgcn_sched_barrier(0)
    Unit cur, nxt; int ui = 0;
    if (!S.next(0, cur)) return;
    f32x4 acc[2][2][4][2];
#pragma unroll
    for (int a = 0; a < 2; ++a)
#pragma unroll
        for (int b = 0; b < 2; ++b)
#pragma unroll
            for (int m = 0; m < 4; ++m)
#pragma unroll
                for (int n = 0; n < 2; ++n) acc[a][b][m][n] = (f32x4){0.f, 0.f, 0.f, 0.f};
    bf16x8 At[4][2], B0[2][2], B1[2][2];
    const char* cA = (const char*)g.A + (size_t)cur.pm * tstepA; const char* cB = (const char*)g.Bt + (size_t)cur.pn * tstep;
    S.a_ready(cur);
    if constexpr (SP2) {
        PG8_STAGE(PG8_SB(0, 0), cB, voffB); PG8_STAGE(PG8_SB(0, 1), cB + hstep, voffB); PG8_STAGE(PG8_SA(0, 0), cA, voffA); PG8_STAGE(PG8_SA(0, 1), cA + hstepA, voffA);
        if (wr == 1) PG8_BAR;
        PG8_WAIT_V(2); PG8_BAR;
        PG8_STAGE(PG8_SB(1, 0), cB + kstep, voffB); PG8_STAGE(PG8_SA(1, 0), cA + kstepA, voffA); PG8_STAGE(PG8_SB(1, 1), cB + hstep + kstep, voffB);
        PG8_WAIT_V(6); PG8_BAR;
    } else {
        PG8_STAGE(PG8_SB(0, 0), cB, voffB); PG8_STAGE(PG8_SA(0, 0), cA, voffA); PG8_STAGE(PG8_SB(0, 1), cB + hstep, voffB); PG8_STAGE(PG8_SA(0, 1), cA + hstepA, voffA);
        if (wr == 1) PG8_BAR;
        PG8_WAIT_V(4); PG8_BAR;
        PG8_STAGE(PG8_SB(1, 0), cB + kstep, voffB); PG8_STAGE(PG8_SA(1, 0), cA + kstepA, voffA); PG8_STAGE(PG8_SB(1, 1), cB + hstep + kstep, voffB);
        PG8_WAIT_V(6); PG8_BAR;
    }
    for (;;) {
        const bool has_next = S.next(ui + 1, nxt);
        const char* nA = has_next ? (const char*)g.A + (size_t)nxt.pm * tstepA : cA; const char* nB = has_next ? (const char*)g.Bt + (size_t)nxt.pn * tstep : cB;
        for (int t = 0; t < nt; t += 2) {
            const bool last = (t == nt - 2);
            const char* a1 = cA + (size_t)(t + 1) * kstepA;
            const char* a2 = last ? nA : cA + (size_t)(t + 2) * kstepA; const char* b2 = last ? nB : cB + (size_t)(t + 2) * kstep;
            const char* a3 = a2 + kstepA; const char* b3 = b2 + kstep;
            if (last && has_next) S.a_ready(nxt);
            if constexpr (Epi::MIDK) {
                if (t == Epi::MID0 || t == Epi::MID1) { if (wr == 0) PG8_BAR; E.mid(acc, cur, wr, wc, fr, fq, t == Epi::MID0 ? 0 : 1); if (wr == 1) PG8_BAR; }
            }
            if constexpr (SP2) {
            PG8_LDB(B0, 0, 0); PG8_LDB(B1, 0, 1); PG8_SCHED; PG8_LDA(At, 0, 0); PG8_STAGE(PG8_SA(1, 1), a1 + hstepA, voffA);
            PG8_WAIT_V(8); PG8_WAIT_L(0); PG8_BAR; PG8_MMA(0, 0, At, B0); PG8_MMA(0, 1, At, B1); PG8_BAR; PG8_SCHED;
            PG8_LDA(At, 0, 1); PG8_STAGE(PG8_SB(0, 0), b2, voffB); PG8_STAGE(PG8_SB(0, 1), b2 + hstep, voffB); PG8_STAGE(PG8_SA(0, 0), a2, voffA);
            PG8_WAIT_V(8); PG8_WAIT_L(0); PG8_BAR; PG8_MMA(1, 0, At, B0); PG8_MMA(1, 1, At, B1); PG8_BAR; PG8_SCHED;
            PG8_LDB(B0, 1, 0); PG8_LDB(B1, 1, 1); PG8_SCHED; PG8_LDA(At, 1, 0); PG8_STAGE(PG8_SA(0, 1), a2 + hstepA, voffA);
            PG8_WAIT_V(8); PG8_WAIT_L(0); PG8_BAR; PG8_MMA(0, 0, At, B0); PG8_MMA(0, 1, At, B1); PG8_BAR; PG8_SCHED;
            PG8_LDA(At, 1, 1); PG8_STAGE(PG8_SB(1, 0), b3, voffB); PG8_STAGE(PG8_SB(1, 1), b3 + hstep, voffB); PG8_STAGE(PG8_SA(1, 0), a3, voffA);
            PG8_WAIT_V(8); PG8_WAIT_L(0); PG8_BAR; PG8_MMA(1, 0, At, B0); PG8_MMA(1, 1, At, B1); PG8_BAR; PG8_SCHED;
            } else {
            PG8_LDB(B0, 0, 0); PG8_SCHED; PG8_LDA(At, 0, 0); PG8_STAGE(PG8_SA(1, 1), a1 + hstepA, voffA);
            PG8_WAIT_L(8); PG8_BAR; PG8_WAIT_L(0); PG8_MMA(0, 0, At, B0); PG8_BAR; PG8_SCHED;
            PG8_LDB(B1, 0, 1); PG8_STAGE(PG8_SB(0, 0), b2, voffB);
            PG8_BAR; PG8_WAIT_L(0); PG8_MMA(0, 1, At, B1); PG8_BAR;
            PG8_LDA(At, 0, 1); PG8_STAGE(PG8_SA(0, 0), a2, voffA);
            PG8_BAR; PG8_WAIT_L(0); PG8_MMA(1, 0, At, B0); PG8_BAR; PG8_SCHED;
            PG8_STAGE(PG8_SB(0, 1), b2 + hstep, voffB);
            PG8_WAIT_V(6); PG8_BAR; PG8_MMA(1, 1, At, B1); PG8_BAR;
            PG8_LDB(B0, 1, 0); PG8_SCHED; PG8_LDA(At, 1, 0); PG8_STAGE(PG8_SA(0, 1), a2 + hstepA, voffA);
            PG8_WAIT_L(8); PG8_BAR; PG8_WAIT_L(0); PG8_MMA(0, 0, At, B0); PG8_BAR; PG8_SCHED;
            PG8_LDB(B1, 1, 1); PG8_STAGE(PG8_SB(1, 0), b3, voffB);
            PG8_BAR; PG8_WAIT_L(0); PG8_MMA(0, 1, At, B1); PG8_BAR;
            PG8_LDA(At, 1, 1); PG8_STAGE(PG8_SA(1, 0), a3, voffA);
            PG8_BAR; PG8_WAIT_L(0); PG8_MMA(1, 0, At, B0); PG8_BAR; PG8_SCHED;
            PG8_STAGE(PG8_SB(1, 1), b3 + hstep, voffB);
            PG8_WAIT_V(6); PG8_BAR; PG8_MMA(1, 1, At, B1); PG8_BAR;
            }
        }
        if constexpr (ALIGN_EPI) { if (wr == 0) PG8_BAR; }
        if constexpr (!Epi::AFTER_DRAIN) { E(acc, cur, wr, wc, fr, fq); S.done(cur); }
        if (!has_next) break;
#pragma unroll
        for (int a = 0; a < 2; ++a)
#pragma unroll
            for (int b = 0; b < 2; ++b)
#pragma unroll
                for (int m = 0; m < 4; ++m)
#pragma unroll
                    for (int n = 0; n < 2; ++n) acc[a][b][m][n] = (f32x4){0.f, 0.f, 0.f, 0.f};
        cur = nxt; cA = nA; cB = nB; ++ui;
        if constexpr (ALIGN_EPI) { if (wr == 1) PG8_BAR; }
    }
    PG8_WAIT_V(0);
    if constexpr (!ALIGN_EPI) { if (wr == 0) PG8_BAR; }
    PG8_BAR;
    if constexpr (Epi::AFTER_DRAIN) { E.fused(acc, cur, wr, wc, fr, fq, lds, wid, lane); S.done(cur); }
#undef PG8_SA
#undef PG8_SB
#undef PG8_STAGE
#undef PG8_LDA
#undef PG8_LDB
#undef PG8_MMA
#undef PG8_CAT
#undef PG8_WAIT_V
#undef PG8_WAIT_L
#undef PG8_BAR
#undef PG8_SCHED
}
}
#define GAS __attribute__((address_space(1)))
#define LAS __attribute__((address_space(3)))
typedef unsigned short bf16;
typedef unsigned v4u __attribute__((ext_vector_type(4)));
typedef float f32x4 __attribute__((ext_vector_type(4)));
typedef short bf16x8 __attribute__((ext_vector_type(8)));
typedef GAS unsigned gu32;
typedef GAS unsigned long long gu64;
#define RLX_AGENT __ATOMIC_RELAXED, __HIP_MEMORY_SCOPE_AGENT
#define LDS_WAIT() asm volatile("s_waitcnt lgkmcnt(0)" ::: "memory")
#define VM_WAIT() asm volatile("s_waitcnt vmcnt(0)" ::: "memory")
__device__ __forceinline__ unsigned long long rt() { return __builtin_amdgcn_s_memrealtime(); }
__device__ __forceinline__ unsigned f2bf(float f) { unsigned u = __builtin_bit_cast(unsigned, f); return (u + 0x7fffu + ((u >> 16) & 1u)) >> 16; }
__device__ __forceinline__ unsigned pk2(float lo, float hi) { return f2bf(lo) | (f2bf(hi) << 16); }
#define XB_TMO      128
#define XB_XCNT(j)  (256  + 64 * (j))
#define XB_XSUB(j)  (1280 + 64 * (j))
#define XB_XGEN(j)  (2304 + 64 * (j))
#define XB_TOP      3328
#define XB_TOPGEN   3392
#define XCD_BAR_WORDS 3456
#define XB_SPIN_CAP (1u << 18)

__device__ __forceinline__ unsigned xb_ld(unsigned* p)              { return __hip_atomic_load(p, __ATOMIC_RELAXED, __HIP_MEMORY_SCOPE_AGENT); }
__device__ __forceinline__ unsigned xb_add(unsigned* p, unsigned v) { return __hip_atomic_fetch_add(p, v, __ATOMIC_RELAXED, __HIP_MEMORY_SCOPE_AGENT); }
__device__ __forceinline__ unsigned xb_xcc_id() { return (unsigned)__builtin_amdgcn_s_getreg((3 << 11) | 20) & 0xFu; }
#define XB_SPIN(cond, bar) do { unsigned _sp = 0; while (cond) { __builtin_amdgcn_s_sleep(1); \
    if ((++_sp & 255u) == 0u) { if (xb_ld(&(bar)[XB_TMO])) break; if (_sp > XB_SPIN_CAP) { atomicAdd(&(bar)[XB_TMO], 1u); break; } } } } while (0)

struct XcdBarrier {
    unsigned* bar; unsigned x;
    volatile LAS unsigned* st;
};

__device__ __forceinline__ XcdBarrier xcd_barrier_post(unsigned* bar, volatile LAS unsigned* st) {
    XcdBarrier b; b.bar = bar; b.x = xb_xcc_id(); b.st = st;
    if (threadIdx.x == 0) (void)xb_add(&bar[XB_XCNT(b.x)], 1u);
    return b;
}
__device__ __forceinline__ void xcd_barrier_complete(unsigned* bar, unsigned x, unsigned& nloc, unsigned& nx) {
    const unsigned G = gridDim.x * gridDim.y * gridDim.z;
    unsigned sum, cnt, mine, sp = 0u;
    for (;;) {
        sum = 0u; cnt = 0u; mine = 0u;
#pragma unroll
        for (unsigned j = 0; j < 16; ++j) { const unsigned c = xb_ld(&bar[XB_XCNT(j)]); sum += c; cnt += (c > 0u) ? 1u : 0u; mine = (j == x) ? c : mine; }
        if (sum == G) break;
        __builtin_amdgcn_s_sleep(1);
        if ((++sp & 255u) == 0u) { if (xb_ld(&bar[XB_TMO])) break; if (sp > XB_SPIN_CAP) { atomicAdd(&bar[XB_TMO], 1u); break; } }
    }
    nloc = mine > 0u ? mine : 1u; nx = cnt > 0u ? cnt : 1u;
}

__device__ __forceinline__ void xcd_barrier(const XcdBarrier& b) {
    asm volatile("s_waitcnt vmcnt(0)" ::: "memory");
    __syncthreads();
    if (threadIdx.x == 0) {
        unsigned* bar = b.bar;
        __builtin_amdgcn_s_waitcnt(0);
        unsigned nloc = b.st[0], nx = b.st[1];
        if (nloc == 0u) { xcd_barrier_complete(bar, b.x, nloc, nx); b.st[0] = nloc; b.st[1] = nx; }
        const unsigned old = xb_add(&bar[XB_XSUB(b.x)], 1u);
        const unsigned gen = old / nloc;
        if (old + 1u == (gen + 1u) * nloc) {
            __builtin_amdgcn_fence(__ATOMIC_RELEASE, "agent");
            asm volatile("s_waitcnt vmcnt(0)" ::: "memory");
            const unsigned og = xb_add(&bar[XB_TOP], 1u);
            const unsigned tg = og / nx;
            if (og + 1u == (tg + 1u) * nx) xb_add(&bar[XB_TOPGEN], 1u);
            else XB_SPIN(xb_ld(&bar[XB_TOPGEN]) == tg, bar);
            __builtin_amdgcn_fence(__ATOMIC_ACQUIRE, "agent");
            xb_add(&bar[XB_XGEN(b.x)], 1u);
            asm volatile("s_waitcnt vmcnt(0)" ::: "memory");
        } else {
            XB_SPIN(xb_ld(&bar[XB_XGEN(b.x)]) == gen, bar);
            __builtin_amdgcn_fence(__ATOMIC_ACQUIRE, "agent");
            asm volatile("s_waitcnt vmcnt(0)" ::: "memory");
        }
    }
    __syncthreads();
}
namespace att {
typedef unsigned short bf16_t;
typedef short bf16x8 __attribute__((ext_vector_type(8)));
typedef short s16x4 __attribute__((ext_vector_type(4)));
typedef float f32x16 __attribute__((ext_vector_type(16)));
typedef float f32x4 __attribute__((ext_vector_type(4)));
typedef unsigned u32x4 __attribute__((ext_vector_type(4)));
#define ATT_LAS __attribute__((address_space(3)))
#define ATT_SBAR() __builtin_amdgcn_sched_barrier(0)
#ifndef ATT_SPLIT
#define ATT_SPLIT 4
#endif
constexpr int SEQ = 2048, QB = 256, KVBLK = 64, OPITCH = 6144  ;
constexpr int L_K = 0, L_KSZ = 25600, L_V = 2 * L_KSZ, L_VSZ = 16384, L_WS = L_V + 2 * L_VSZ, L_TAB = L_WS + 8 * 256, L_QR = L_TAB + 8192  , L_END = L_QR + 8 * 4096;
constexpr float LOG2E = 1.4426950408889634f;

struct Args {
    const bf16_t* Q; const bf16_t* K; const bf16_t* KR; const bf16_t* V; const bf16_t* Z; bf16_t* O;
    const float* CB;
    const float* relt;
    const float* sinks;
};
template <int KIND> struct Cfg;
template <> struct Cfg<0> { static constexpr int DK = 192, DV = 128, QP = 3072, KP = 2048, VP = 2048, NH = 16, G = 1; };
template <> struct Cfg<1> { static constexpr int DK = 64,  DV = 64,  QP = 2048, KP = 256,  VP = 256,  NH = 32, G = 8; };
template <> struct Cfg<2> { static constexpr int DK = 128, DV = 128, QP = 2048, KP = 2048, VP = 2048, NH = 16, G = 1; };

__device__ __forceinline__ int crow(int r, int hi) { return (r & 3) + 8 * (r >> 2) + 4 * hi; }
typedef float att_f32x2 __attribute__((ext_vector_type(2))); typedef __bf16 att_bf16x2 __attribute__((ext_vector_type(2)));
__device__ __forceinline__ unsigned cvtpk(float lo, float hi) { const att_f32x2 v = {lo, hi}; const att_bf16x2 b = __builtin_convertvector(v, att_bf16x2); return __builtin_bit_cast(unsigned, b); }
template <int DV> __device__ __forceinline__ int v_st(int k, int c) { constexpr int NS = DV / 32; const int kk = (k & ~0xC) | ((k & 4) << 1) | ((k & 8) >> 1); return ((kk >> 3) * NS + (c >> 5)) * 512 + ((kk & 7) * 32 + (c & 31)) * 2; }
__device__ __forceinline__ int v_rd_base(int lane) { return ((lane & 3) << 3) | (((lane >> 2) & 3) << 6) | (((lane >> 4) & 1) << 5) | (((lane >> 5) & 1) << 8); }
template <int DK> __device__ __forceinline__ int k_st(int row, int ch) { return row * (DK * 2) + ((ch ^ (row & 7)) << 4); }

template <int DK, bool BIAS>
__device__ __forceinline__ void qkt(f32x16& p0, f32x16& p1, ATT_LAS const unsigned char* Kt, int r32, int hi, const bf16x8* qr, ATT_LAS const float* bp) {
    if constexpr (BIAS) {
#pragma unroll
        for (int g = 0; g < 4; ++g) { const f32x4 a = *(ATT_LAS const f32x4*)(bp + 8 * g), b = *(ATT_LAS const f32x4*)(bp + 32 + 8 * g);
            p0[4 * g] = a[0]; p0[4 * g + 1] = a[1]; p0[4 * g + 2] = a[2]; p0[4 * g + 3] = a[3]; p1[4 * g] = b[0]; p1[4 * g + 1] = b[1]; p1[4 * g + 2] = b[2]; p1[4 * g + 3] = b[3]; }
    } else { p0 = f32x16{}; p1 = f32x16{}; }
    ATT_LAS const unsigned char* kb[4];
#pragma unroll
    for (int dd = 0; dd < 4; ++dd) kb[dd] = Kt + r32 * (DK * 2) + (((2 * dd + hi) ^ (r32 & 7)) << 4);
#pragma unroll
    for (int d0 = 0; d0 < DK / 16; ++d0) { ATT_LAS const unsigned char* a = kb[d0 & 3] + (d0 >> 2) * 128;
        const bf16x8 b0 = *(ATT_LAS const bf16x8*)a;
        const bf16x8 b1 = *(ATT_LAS const bf16x8*)(a + 32 * DK * 2);
        p0 = __builtin_amdgcn_mfma_f32_32x32x16_bf16(b0, qr[d0], p0, 0, 0, 0);
        p1 = __builtin_amdgcn_mfma_f32_32x32x16_bf16(b1, qr[d0], p1, 0, 0, 0); }
}
template <int DV>
__device__ __forceinline__ void pv_tile(f32x16* o, int vb0, bf16x8 pa0, bf16x8 pa1, bf16x8 pa2, bf16x8 pa3) {
    constexpr int NS = DV / 32, HS = NS * 512, KS = 2 * HS;
#define ATT_TRRD(dst, off) asm volatile("ds_read_b64_tr_b16 %0, %1 offset:%2" : "=&v"(dst) : "v"(vb0), "i"(off) : "memory")
#pragma unroll
    for (int d0 = 0; d0 < NS; ++d0) { s16x4 l0, l1, l2, l3, h0, h1, h2, h3;
        switch (d0) {
        case 0: ATT_TRRD(l0, 0 * 512); ATT_TRRD(h0, 0 * 512 + HS); ATT_TRRD(l1, 0 * 512 + KS); ATT_TRRD(h1, 0 * 512 + KS + HS); ATT_TRRD(l2, 0 * 512 + 2 * KS); ATT_TRRD(h2, 0 * 512 + 2 * KS + HS); ATT_TRRD(l3, 0 * 512 + 3 * KS); ATT_TRRD(h3, 0 * 512 + 3 * KS + HS); break;
        case 1: ATT_TRRD(l0, 1 * 512); ATT_TRRD(h0, 1 * 512 + HS); ATT_TRRD(l1, 1 * 512 + KS); ATT_TRRD(h1, 1 * 512 + KS + HS); ATT_TRRD(l2, 1 * 512 + 2 * KS); ATT_TRRD(h2, 1 * 512 + 2 * KS + HS); ATT_TRRD(l3, 1 * 512 + 3 * KS); ATT_TRRD(h3, 1 * 512 + 3 * KS + HS); break;
        case 2: ATT_TRRD(l0, 2 * 512); ATT_TRRD(h0, 2 * 512 + HS); ATT_TRRD(l1, 2 * 512 + KS); ATT_TRRD(h1, 2 * 512 + KS + HS); ATT_TRRD(l2, 2 * 512 + 2 * KS); ATT_TRRD(h2, 2 * 512 + 2 * KS + HS); ATT_TRRD(l3, 2 * 512 + 3 * KS); ATT_TRRD(h3, 2 * 512 + 3 * KS + HS); break;
        default: ATT_TRRD(l0, 3 * 512); ATT_TRRD(h0, 3 * 512 + HS); ATT_TRRD(l1, 3 * 512 + KS); ATT_TRRD(h1, 3 * 512 + KS + HS); ATT_TRRD(l2, 3 * 512 + 2 * KS); ATT_TRRD(h2, 3 * 512 + 2 * KS + HS); ATT_TRRD(l3, 3 * 512 + 3 * KS); ATT_TRRD(h3, 3 * 512 + 3 * KS + HS); break;
        }
        asm volatile("s_waitcnt lgkmcnt(0)" ::: "memory"); ATT_SBAR();
        o[d0] = __builtin_amdgcn_mfma_f32_32x32x16_bf16(pa0, (bf16x8){l0[0], l0[1], l0[2], l0[3], h0[0], h0[1], h0[2], h0[3]}, o[d0], 0, 0, 0);
        o[d0] = __builtin_amdgcn_mfma_f32_32x32x16_bf16(pa1, (bf16x8){l1[0], l1[1], l1[2], l1[3], h1[0], h1[1], h1[2], h1[3]}, o[d0], 0, 0, 0);
        o[d0] = __builtin_amdgcn_mfma_f32_32x32x16_bf16(pa2, (bf16x8){l2[0], l2[1], l2[2], l2[3], h2[0], h2[1], h2[2], h2[3]}, o[d0], 0, 0, 0);
        o[d0] = __builtin_amdgcn_mfma_f32_32x32x16_bf16(pa3, (bf16x8){l3[0], l3[1], l3[2], l3[3], h3[0], h3[1], h3[2], h3[3]}, o[d0], 0, 0, 0); }
#undef ATT_TRRD
}

template <int ND>
__device__ __forceinline__ void attn_epilogue(const f32x16* o, float l_reg, ATT_LAS float* li_l, ATT_LAS float* stage, const bf16_t* Zrow0, bf16_t* Orow0, int lane) {
    const int r32 = lane & 31, hi = lane >> 5;
    if (hi == 0) li_l[r32] = l_reg;
    asm volatile("s_waitcnt lgkmcnt(0)" ::: "memory");
    float rl[16];
#pragma unroll
    for (int g = 0; g < 4; ++g) { const f32x4 l4 = *(ATT_LAS const f32x4*)(li_l + 8 * g + 4 * hi);
#pragma unroll
        for (int e = 0; e < 4; ++e) rl[4 * g + e] = __builtin_amdgcn_rcpf(l4[e]); }
#pragma unroll
    for (int half = 0; half < ND / 2; ++half) {
#pragma unroll
        for (int dd = 0; dd < 2; ++dd)
#pragma unroll
            for (int r = 0; r < 16; ++r) stage[((r & 3) + 8 * (r >> 2) + 4 * hi) * 68 + dd * 32 + r32] = o[2 * half + dd][r] * rl[r];
        asm volatile("s_waitcnt lgkmcnt(0)" ::: "memory");
#pragma unroll
        for (int j = 0; j < 4; ++j) { const int id = lane + 64 * j, row = id >> 3, cg = id & 7;
            const f32x4 a0 = *(ATT_LAS const f32x4*)(stage + row * 68 + cg * 8), a1 = *(ATT_LAS const f32x4*)(stage + row * 68 + cg * 8 + 4);
            const size_t off = (size_t)row * 2048 + half * 64 + cg * 8, offo = (size_t)row * OPITCH + half * 64 + cg * 8;
            const u32x4 zz = *(const u32x4*)(Zrow0 + off);
            float z[8] = {__uint_as_float(zz.x << 16), __uint_as_float(zz.x & 0xffff0000u), __uint_as_float(zz.y << 16), __uint_as_float(zz.y & 0xffff0000u),
                          __uint_as_float(zz.z << 16), __uint_as_float(zz.z & 0xffff0000u), __uint_as_float(zz.w << 16), __uint_as_float(zz.w & 0xffff0000u)};
            float v[8] = {a0[0], a0[1], a0[2], a0[3], a1[0], a1[1], a1[2], a1[3]};
#pragma unroll
            for (int e = 0; e < 8; ++e) v[e] = v[e] * z[e] * __builtin_amdgcn_rcpf(1.0f + __builtin_amdgcn_exp2f(-LOG2E * z[e]));
            u32x4 w = {cvtpk(v[0], v[1]), cvtpk(v[2], v[3]), cvtpk(v[4], v[5]), cvtpk(v[6], v[7])};
            *(u32x4*)(Orow0 + offo) = w; }
        asm volatile("s_waitcnt lgkmcnt(0)" ::: "memory");
    }
}

template <int KIND, int VAR = 0, int ORDER = 0>
__device__ __forceinline__ void attn_unit_o(const Args& T, int b, int h, int qb, ATT_LAS unsigned char* lds) {
    typedef Cfg<KIND> C; constexpr int DK = C::DK, DV = C::DV, QP = C::QP, KP = C::KP, VP = C::VP, NQF = DK / 16, ND = DV / 32;
    constexpr int KROW = DK * 2, KBUF = 64 * KROW, VBUF = 64 * DV * 2, LK = 0, LV = 3 * KBUF, LWS = LV + 3 * VBUF, LTAB = LWS + 8 * 256, LEND = LTAB + (KIND == 2 ? 8192 : 0);
    constexpr int NDK = KBUF / 8192, NDV = VBUF / 8192, NDMA = NDK + NDV;
    static_assert(LEND <= 131072 && KIND != 1, "attention LDS");
    int tid_l = threadIdx.x; asm volatile("" : "+v"(tid_l));
    const int tid = tid_l, wid = __builtin_amdgcn_readfirstlane(tid >> 6), lane = tid & 63, r32 = lane & 31, hi = lane >> 5;
    const int P0 = qb * QB;
    const size_t tok0 = (size_t)b * SEQ;
    const int j_hi = (P0 + QB) / KVBLK;
    const int qlo = P0 + wid * 32, qpos = qlo + r32;
    ATT_LAS unsigned char* K_lds = lds + LK; ATT_LAS unsigned char* V_lds = lds + LV;
    ATT_LAS float* wsf = (ATT_LAS float*)(lds + LWS) + wid * 64; ATT_LAS float* li_l = wsf; ATT_LAS float* al_l = wsf + 32;
    ATT_LAS float* tab = (ATT_LAS float*)(lds + LTAB);
    const int vb0 = (int)(unsigned)(uintptr_t)V_lds + v_rd_base(lane);
    const bf16_t* Kg = T.K + tok0 * KP + h * (KIND == 0 ? 128 : DK);
    const bf16_t* Vg = T.V + tok0 * VP + h * DV;
    const bf16_t* KRg = T.KR + tok0 * 64;
    int ksrc[NDK]; bool kro[NDK]; int vsrc[NDV];
#pragma unroll
    for (int i = 0; i < NDK; ++i) {
        if constexpr (KIND == 2) { const int row = 4 * (wid * NDK + i) + (lane >> 4), c = (lane & 15) ^ (row & 15); ksrc[i] = row * KP + c * 8; kro[i] = false; }
        else { const int q = 64 * (wid * NDK + i) + lane, row = q / 24, slot = q - row * 24, gs = slot >> 3, c = gs * 8 + ((slot & 7) ^ ((row >> 1) & 7));
               kro[i] = gs == 2; ksrc[i] = kro[i] ? row * 64 + (c - 16) * 8 : row * KP + c * 8; }
    }
#pragma unroll
    for (int i = 0; i < NDV; ++i) { const int S = 2 * (wid * NDV + i) + (lane >> 5), kk = (S >> 2) * 8 + ((lane & 31) >> 2), k = (kk & ~0xC) | ((kk & 4) << 1) | ((kk & 8) >> 1);
        vsrc[i] = k * VP + (S & 3) * 32 + (lane & 3) * 8; }
#define ATT_DMAK(tile_) do { const int tl_ = (tile_) < j_hi ? (tile_) : j_hi - 1; const int bf_ = tl_ % 3; _Pragma("unroll") for (int i_ = 0; i_ < NDK; ++i_) { \
        const bf16_t* sp_ = (KIND == 0 && kro[i_]) ? KRg + (size_t)tl_ * KVBLK * 64 + ksrc[i_] : Kg + (size_t)tl_ * KVBLK * KP + ksrc[i_]; \
        __builtin_amdgcn_global_load_lds((const unsigned*)sp_, (ATT_LAS unsigned*)(K_lds + bf_ * KBUF + (wid * NDK + i_) * 1024), 16, 0, 0); } } while (0)
#define ATT_DMAV(tile_) do { const int tl_ = (tile_) < j_hi ? (tile_) : j_hi - 1; const int bf_ = tl_ % 3; _Pragma("unroll") for (int i_ = 0; i_ < NDV; ++i_) \
        __builtin_amdgcn_global_load_lds((const unsigned*)(Vg + (size_t)tl_ * KVBLK * VP + vsrc[i_]), (ATT_LAS unsigned*)(V_lds + bf_ * VBUF + (wid * NDV + i_) * 1024), 16, 0, 0); } while (0)
    const int kl0 = r32 * KROW + ((hi ^ (KIND == 2 ? (r32 & 15) : ((r32 >> 1) & 7))) << 4);
#define ATT_KFRAG(dst, d0_) do { const int ko_ = (kl0 ^ (((d0_) & (KIND == 2 ? 7 : 3)) << 5)) + (KIND == 2 ? 0 : ((d0_) >> 2) * 128); \
        dst[0] = *(ATT_LAS const bf16x8*)(kt_ + ko_); dst[1] = *(ATT_LAS const bf16x8*)(kt_ + ko_ + 32 * KROW); } while (0)
#define ATT_QKT(PX0, PX1, kbf_, kb_) do { \
        ATT_LAS const unsigned char* kt_ = K_lds + (kbf_) * KBUF; \
        bf16x8 kfa_[2], kfb_[2]; \
        ATT_KFRAG(kfa_, 0); ATT_KFRAG(kfb_, 1); \
        if constexpr (KIND == 2) { ATT_LAS const float* bp = tab + (kb_) + 4 * hi; _Pragma("unroll") for (int g = 0; g < 4; ++g) { const f32x4 a_ = *(ATT_LAS const f32x4*)(bp + 8 * g), b_ = *(ATT_LAS const f32x4*)(bp + 32 + 8 * g); \
                PX0[4 * g] = a_[0]; PX0[4 * g + 1] = a_[1]; PX0[4 * g + 2] = a_[2]; PX0[4 * g + 3] = a_[3]; PX1[4 * g] = b_[0]; PX1[4 * g + 1] = b_[1]; PX1[4 * g + 2] = b_[2]; PX1[4 * g + 3] = b_[3]; } } \
        else { PX0 = f32x16{}; PX1 = f32x16{}; } \
        _Pragma("unroll") for (int d0 = 0; d0 < NQF; d0 += 2) { \
            PX0 = __builtin_amdgcn_mfma_f32_32x32x16_bf16(kfa_[0], qr[d0], PX0, 0, 0, 0); PX1 = __builtin_amdgcn_mfma_f32_32x32x16_bf16(kfa_[1], qr[d0], PX1, 0, 0, 0); \
            if (d0 + 2 < NQF) ATT_KFRAG(kfa_, d0 + 2); \
            ATT_SBAR(); \
            PX0 = __builtin_amdgcn_mfma_f32_32x32x16_bf16(kfb_[0], qr[d0 + 1], PX0, 0, 0, 0); PX1 = __builtin_amdgcn_mfma_f32_32x32x16_bf16(kfb_[1], qr[d0 + 1], PX1, 0, 0, 0); \
            if (d0 + 3 < NQF) ATT_KFRAG(kfb_, d0 + 3); \
            ATT_SBAR(); } } while (0)
#define ATT_ACT(kb_) ((kb_) <= qlo + 31)
    ATT_DMAK(0); ATT_DMAV(0); ATT_DMAK(1); ATT_DMAV(1); ATT_DMAK(2);
    bf16x8 qr[NQF];
    { const bf16_t* Qw = T.Q + (tok0 + qpos) * QP + h * DK + hi * 8;
#pragma unroll
      for (int d0 = 0; d0 < NQF; ++d0) qr[d0] = *(const bf16x8*)(Qw + d0 * 16); }
    if constexpr (KIND == 2) { const float* cb = T.CB + ((size_t)b * 16 + h) * SEQ; for (int i = tid; i < P0 + QB; i += 512) tab[i] = cb[i]; }
    float m_reg = -1e30f, l_reg = 0.f;
    f32x16 o[ND];
#pragma unroll
    for (int d = 0; d < ND; ++d) o[d] = f32x16{};
    asm volatile("s_waitcnt vmcnt(0)" ::: "memory");
    __syncthreads();
#define ATT_PK4(P, B_, OUT) do { unsigned a0 = cvtpk(P[B_ + 0], P[B_ + 1]), a1 = cvtpk(P[B_ + 2], P[B_ + 3]); \
            unsigned b0 = cvtpk(P[B_ + 4], P[B_ + 5]), b1 = cvtpk(P[B_ + 6], P[B_ + 7]); \
            auto r0 = __builtin_amdgcn_permlane32_swap(a0, b0, false, false); auto r1 = __builtin_amdgcn_permlane32_swap(a1, b1, false, false); \
            u32x4 w = {r0[0], r1[0], r0[1], r1[1]}; OUT = __builtin_bit_cast(bf16x8, w); } while (0)
#define ATT_STEP(PC0, PC1, PN0, PN1, t_) do { \
        const int t = (t_); const int kb = t * KVBLK, vbf = t % 3, kbn = (t + 1) % 3; \
        ATT_DMAK(t + 3); ATT_DMAV(t + 2); \
        ATT_SBAR(); \
        const bool actn = (t + 1 < j_hi) && ATT_ACT(kb + KVBLK); \
        if constexpr (ORDER == 0) { \
        if (actn) { if constexpr (VAR == 3 || VAR == 4) { PN0 = f32x16{}; PN1 = f32x16{}; } else ATT_QKT(PN0, PN1, kbn, kb + KVBLK); } \
        ATT_SBAR(); \
        if (VAR != 4 && ATT_ACT(kb)) { \
            const int dq = qpos - kb - 4 * hi; \
            if (kb + KVBLK - 1 > qlo) { const float NEG = -__builtin_inff(); \
_Pragma("unroll") \
                for (int r = 0; r < 16; ++r) { const int c = (r & 3) + 8 * (r >> 2); \
                    if (dq - c < 0) PC0[r] = NEG; \
                    if (dq - c - 32 < 0) PC1[r] = NEG; } } \
            if constexpr (VAR != 1) { \
            float pmax = PC0[0]; \
_Pragma("unroll") \
            for (int r = 1; r < 16; ++r) pmax = fmaxf(pmax, PC0[r]); \
_Pragma("unroll") \
            for (int r = 0; r < 16; ++r) pmax = fmaxf(pmax, PC1[r]); \
            { auto rr = __builtin_amdgcn_permlane32_swap(__float_as_uint(pmax), __float_as_uint(pmax), false, false); \
              pmax = fmaxf(__uint_as_float(rr[0]), __uint_as_float(rr[1])); } \
            const float mn = fmaxf(m_reg, pmax); \
            const float alpha = __builtin_amdgcn_exp2f(m_reg - mn); \
            m_reg = mn; \
            float ps = 0.f; \
_Pragma("unroll") \
            for (int r = 0; r < 16; ++r) { PC0[r] = __builtin_amdgcn_exp2f(PC0[r] - mn); ps += PC0[r]; } \
_Pragma("unroll") \
            for (int r = 0; r < 16; ++r) { PC1[r] = __builtin_amdgcn_exp2f(PC1[r] - mn); ps += PC1[r]; } \
            { auto rr = __builtin_amdgcn_permlane32_swap(__float_as_uint(ps), __float_as_uint(ps), false, false); \
              ps = __uint_as_float(rr[0]) + __uint_as_float(rr[1]); } \
            l_reg = l_reg * alpha + ps; \
            if (__any(alpha < 1.f)) { \
                if (hi == 0) al_l[r32] = alpha; \
                asm volatile("s_waitcnt lgkmcnt(0)" ::: "memory"); \
_Pragma("unroll") \
                for (int g = 0; g < 4; ++g) { const f32x4 a4 = *(ATT_LAS const f32x4*)(al_l + 8 * g + 4 * hi); \
_Pragma("unroll") \
                    for (int d = 0; d < ND; ++d) { o[d][4 * g] *= a4[0]; o[d][4 * g + 1] *= a4[1]; o[d][4 * g + 2] *= a4[2]; o[d][4 * g + 3] *= a4[3]; } } \
            } \
            } \
            bf16x8 pa0, pa1, pa2, pa3; \
            ATT_PK4(PC0, 0, pa0); ATT_PK4(PC0, 8, pa1); ATT_PK4(PC1, 0, pa2); ATT_PK4(PC1, 8, pa3); \
            if constexpr (VAR != 2) pv_tile<DV>(o, vb0 + vbf * VBUF, pa0, pa1, pa2, pa3); else { o[0][0] += __builtin_bit_cast(float, pa0[0] + pa1[1] + pa2[2] + pa3[3]) * 1e-30f; } \
        } \
        } else { \
        if (VAR != 4 && ATT_ACT(kb)) { \
            const int dq = qpos - kb - 4 * hi; \
            if (kb + KVBLK - 1 > qlo) { const float NEG = -__builtin_inff(); \
_Pragma("unroll") \
                for (int r = 0; r < 16; ++r) { const int c = (r & 3) + 8 * (r >> 2); \
                    if (dq - c < 0) PC0[r] = NEG; \
                    if (dq - c - 32 < 0) PC1[r] = NEG; } } \
            if constexpr (VAR != 1) { \
            float pmax = PC0[0]; \
_Pragma("unroll") \
            for (int r = 1; r < 16; ++r) pmax = fmaxf(pmax, PC0[r]); \
_Pragma("unroll") \
            for (int r = 0; r < 16; ++r) pmax = fmaxf(pmax, PC1[r]); \
            { auto rr = __builtin_amdgcn_permlane32_swap(__float_as_uint(pmax), __float_as_uint(pmax), false, false); \
              pmax = fmaxf(__uint_as_float(rr[0]), __uint_as_float(rr[1])); } \
            const float mn = fmaxf(m_reg, pmax); \
            const float alpha = __builtin_amdgcn_exp2f(m_reg - mn); \
            m_reg = mn; \
            float ps = 0.f; \
_Pragma("unroll") \
            for (int r = 0; r < 16; ++r) { PC0[r] = __builtin_amdgcn_exp2f(PC0[r] - mn); ps += PC0[r]; } \
_Pragma("unroll") \
            for (int r = 0; r < 16; ++r) { PC1[r] = __builtin_amdgcn_exp2f(PC1[r] - mn); ps += PC1[r]; } \
            { auto rr = __builtin_amdgcn_permlane32_swap(__float_as_uint(ps), __float_as_uint(ps), false, false); \
              ps = __uint_as_float(rr[0]) + __uint_as_float(rr[1]); } \
            l_reg = l_reg * alpha + ps; \
            if (__any(alpha < 1.f)) { \
                if (hi == 0) al_l[r32] = alpha; \
                asm volatile("s_waitcnt lgkmcnt(0)" ::: "memory"); \
_Pragma("unroll") \
                for (int g = 0; g < 4; ++g) { const f32x4 a4 = *(ATT_LAS const f32x4*)(al_l + 8 * g + 4 * hi); \
_Pragma("unroll") \
                    for (int d = 0; d < ND; ++d) { o[d][4 * g] *= a4[0]; o[d][4 * g + 1] *= a4[1]; o[d][4 * g + 2] *= a4[2]; o[d][4 * g + 3] *= a4[3]; } } \
            } \
            } \
            bf16x8 pa0, pa1, pa2, pa3; \
            ATT_PK4(PC0, 0, pa0); ATT_PK4(PC0, 8, pa1); ATT_PK4(PC1, 0, pa2); ATT_PK4(PC1, 8, pa3); \
            if constexpr (VAR != 2) pv_tile<DV>(o, vb0 + vbf * VBUF, pa0, pa1, pa2, pa3); else { o[0][0] += __builtin_bit_cast(float, pa0[0] + pa1[1] + pa2[2] + pa3[3]) * 1e-30f; } \
        } \
        ATT_SBAR(); \
        if (actn) { if constexpr (VAR == 3 || VAR == 4) { PN0 = f32x16{}; PN1 = f32x16{}; } else ATT_QKT(PN0, PN1, kbn, kb + KVBLK); } \
        } \
        ATT_SBAR(); \
        asm volatile("s_waitcnt vmcnt(%0) lgkmcnt(0)" :: "n"(NDMA) : "memory");        \
        __builtin_amdgcn_s_barrier(); asm volatile("" ::: "memory"); \
    } while (0)
    f32x16 pA0, pA1, pB0, pB1;
    ATT_QKT(pA0, pA1, 0, 0);
    __syncthreads();
    for (int tt = 0; tt < j_hi; tt += 2) {
        ATT_STEP(pA0, pA1, pB0, pB1, tt);
        ATT_STEP(pB0, pB1, pA0, pA1, tt + 1);
    }
#undef ATT_STEP
#undef ATT_PK4
    asm volatile("s_waitcnt vmcnt(0)" ::: "memory");
    __syncthreads();
    { const size_t ro = (tok0 + P0 + wid * 32) * 2048 + (size_t)h * DV, roo = (tok0 + P0 + wid * 32) * OPITCH + (size_t)h * DV;
      attn_epilogue<ND>(o, l_reg, li_l, (ATT_LAS float*)(lds + wid * 8704), T.Z + ro, T.O + roo, lane); }
    __syncthreads();
#undef ATT_DMAK
#undef ATT_DMAV
#undef ATT_QKT
#undef ATT_KFRAG
#undef ATT_ACT
}

template <int KIND, int VAR = 0>
__device__ __forceinline__ void attn_unit(const Args& T, int b, int h, int qb, ATT_LAS unsigned char* lds) {
    const int wv = __builtin_amdgcn_readfirstlane((int)threadIdx.x >> 6);
    if (wv < ATT_SPLIT) attn_unit_o<KIND, VAR, 0>(T, b, h, qb, lds); else attn_unit_o<KIND, VAR, 1>(T, b, h, qb, lds);
}

constexpr int LB_KROW = 144, LB_K = 0, LB_V = 384 * LB_KROW, LB_TAB = LB_V + 6 * 8192, LB_TABN = 320  , LB_WS = LB_TAB + 8 * LB_TABN * 4, LB_ST = LB_WS + 8 * 256  , LB_END = LB_ST + 8 * 2560;
__device__ __forceinline__ void attn_unit_b(const Args& T, int b, int kvh, int qb, ATT_LAS unsigned char* lds) {
    constexpr int QP = 2048, KP = 256;
    int tid_l = threadIdx.x; asm volatile("" : "+v"(tid_l));
    const int tid = tid_l, wid = __builtin_amdgcn_readfirstlane(tid >> 6), lane = tid & 63, r32 = lane & 31, hi = lane >> 5;
    const int P0 = qb * QB; const size_t tok0 = (size_t)b * SEQ;
    const int j_lo = P0 >= QB ? (P0 - 128) / KVBLK : 0, NT = (P0 + QB) / KVBLK - j_lo, kb0 = j_lo * KVBLK;
    const int qlo = P0 + wid * 32, qpos = qlo + r32;
    ATT_LAS unsigned char* K_lds = lds + LB_K; ATT_LAS unsigned char* V_lds = lds + LB_V;
    ATT_LAS float* wsf = (ATT_LAS float*)(lds + LB_WS) + wid * 64; ATT_LAS float* li_l = wsf; ATT_LAS float* al_l = wsf + 32;
    const int vb0 = (int)(unsigned)(uintptr_t)V_lds + v_rd_base(lane);
    {
        const bf16_t* Kg = T.K + (tok0 + kb0) * KP + kvh * 64; const bf16_t* Vg = T.V + (tok0 + kb0) * KP + kvh * 64;
        const int sr8 = tid >> 3, sc8 = tid & 7;
        bf16x8 sk[6], sv[6];
#pragma unroll
        for (int i = 0; i < 6; ++i) if (i < NT) { sk[i] = *(const bf16x8*)(Kg + (size_t)(64 * i + sr8) * KP + sc8 * 8); sv[i] = *(const bf16x8*)(Vg + (size_t)(64 * i + sr8) * KP + sc8 * 8); }
        for (int j = tid; j < 8 * LB_TABN; j += 512) { const int g = j / LB_TABN, e = j - g * LB_TABN + 160, d = 383 - e; float v = 0.f;
            if (d >= 0 && d < 128) { int bk = d; if (d >= 16) { bk = 16 + (int)(__logf((float)d * (1.0f / 16.0f)) / 2.0794415416798357f * 16.0f); bk = bk > 31 ? 31 : bk; } v = T.relt[bk * 32 + kvh * 8 + g] * LOG2E; }
            ((ATT_LAS float*)(lds + LB_TAB))[j] = v; }
#pragma unroll
        for (int i = 0; i < 6; ++i) if (i < NT) { *(ATT_LAS bf16x8*)(K_lds + (64 * i + sr8) * LB_KROW + sc8 * 16) = sk[i]; *(ATT_LAS bf16x8*)(V_lds + i * 8192 + v_st<64>(sr8, sc8 * 8)) = sv[i]; }
    }
    __syncthreads();
    bf16x8 qn[4];
    { const bf16_t* Qw = T.Q + (tok0 + qpos) * QP + (kvh * 8) * 64 + hi * 8;
#pragma unroll
      for (int d0 = 0; d0 < 4; ++d0) qn[d0] = *(const bf16x8*)(Qw + d0 * 16); }
    for (int g = 0; g < 8; ++g) {
        const int h = kvh * 8 + g;
        bf16x8 qr[4];
#pragma unroll
        for (int d0 = 0; d0 < 4; ++d0) qr[d0] = qn[d0];
        if (g < 7) { const bf16_t* Qw = T.Q + (tok0 + qpos) * QP + (h + 1) * 64 + hi * 8;
#pragma unroll
            for (int d0 = 0; d0 < 4; ++d0) qn[d0] = *(const bf16x8*)(Qw + d0 * 16); }
        ATT_LAS const float* tabg = (ATT_LAS const float*)(lds + LB_TAB) + g * LB_TABN - 160;
        float m_reg = T.sinks[h] * LOG2E, l_reg = 1.f;
        f32x16 o[2]; o[0] = f32x16{}; o[1] = f32x16{};
        for (int t = 0; t < NT; ++t) {
            const int kb = kb0 + t * KVBLK;
            if (!(kb <= qlo + 31 && kb + KVBLK - 1 >= qlo - 127)) continue;
            f32x16 p0 = f32x16{}, p1 = f32x16{};
            { ATT_LAS const unsigned char* ka = K_lds + (t * 64 + r32) * LB_KROW + hi * 16;
#pragma unroll
              for (int d0 = 0; d0 < 4; ++d0) { const bf16x8 b0 = *(ATT_LAS const bf16x8*)(ka + d0 * 32), b1 = *(ATT_LAS const bf16x8*)(ka + d0 * 32 + 32 * LB_KROW);
                  p0 = __builtin_amdgcn_mfma_f32_32x32x16_bf16(b0, qr[d0], p0, 0, 0, 0); p1 = __builtin_amdgcn_mfma_f32_32x32x16_bf16(b1, qr[d0], p1, 0, 0, 0); } }
            const int dq = qpos - kb - 4 * hi;
            { ATT_LAS const float* tp = tabg + (383 - dq); const float NEG = -__builtin_inff();
#pragma unroll
              for (int r = 0; r < 16; ++r) { const int c = (r & 3) + 8 * (r >> 2); p0[r] += tp[c]; p1[r] += tp[c + 32];
                  if ((unsigned)(dq - c) >= 128u) p0[r] = NEG;
                  if ((unsigned)(dq - c - 32) >= 128u) p1[r] = NEG; } }
            float pmax = p0[0];
#pragma unroll
            for (int r = 1; r < 16; ++r) pmax = fmaxf(pmax, p0[r]);
#pragma unroll
            for (int r = 0; r < 16; ++r) pmax = fmaxf(pmax, p1[r]);
            { auto rr = __builtin_amdgcn_permlane32_swap(__float_as_uint(pmax), __float_as_uint(pmax), false, false); pmax = fmaxf(__uint_as_float(rr[0]), __uint_as_float(rr[1])); }
            const float mn = fmaxf(m_reg, pmax), alpha = __builtin_amdgcn_exp2f(m_reg - mn);
            m_reg = mn;
            float ps = 0.f;
#pragma unroll
            for (int r = 0; r < 16; ++r) { p0[r] = __builtin_amdgcn_exp2f(p0[r] - mn); ps += p0[r]; }
#pragma unroll
            for (int r = 0; r < 16; ++r) { p1[r] = __builtin_amdgcn_exp2f(p1[r] - mn); ps += p1[r]; }
            { auto rr = __builtin_amdgcn_permlane32_swap(__float_as_uint(ps), __float_as_uint(ps), false, false); ps = __uint_as_float(rr[0]) + __uint_as_float(rr[1]); }
            l_reg = l_reg * alpha + ps;
            if (__any(alpha < 1.f)) {
                if (hi == 0) al_l[r32] = alpha;
                asm volatile("s_waitcnt lgkmcnt(0)" ::: "memory");
#pragma unroll
                for (int q = 0; q < 4; ++q) { const f32x4 a4 = *(ATT_LAS const f32x4*)(al_l + 8 * q + 4 * hi);
#pragma unroll
                    for (int d = 0; d < 2; ++d) { o[d][4 * q] *= a4[0]; o[d][4 * q + 1] *= a4[1]; o[d][4 * q + 2] *= a4[2]; o[d][4 * q + 3] *= a4[3]; } }
            }
            bf16x8 pa0, pa1, pa2, pa3;
#define ATT_PK4(P, B_, OUT) do { unsigned a0 = cvtpk(P[B_ + 0], P[B_ + 1]), a1 = cvtpk(P[B_ + 2], P[B_ + 3]); \
            unsigned b0 = cvtpk(P[B_ + 4], P[B_ + 5]), b1 = cvtpk(P[B_ + 6], P[B_ + 7]); \
            auto r0 = __builtin_amdgcn_permlane32_swap(a0, b0, false, false); auto r1 = __builtin_amdgcn_permlane32_swap(a1, b1, false, false); \
            u32x4 w = {r0[0], r1[0], r0[1], r1[1]}; OUT = __builtin_bit_cast(bf16x8, w); } while (0)
            ATT_PK4(p0, 0, pa0); ATT_PK4(p0, 8, pa1); ATT_PK4(p1, 0, pa2); ATT_PK4(p1, 8, pa3);
#undef ATT_PK4
            pv_tile<64>(o, vb0 + t * 8192, pa0, pa1, pa2, pa3);
        }
        if (hi == 0) li_l[r32] = l_reg;
        asm volatile("s_waitcnt lgkmcnt(0)" ::: "memory");
        { float rl[16];
#pragma unroll
          for (int q = 0; q < 4; ++q) { const f32x4 l4 = *(ATT_LAS const f32x4*)(li_l + 8 * q + 4 * hi);
#pragma unroll
              for (int e = 0; e < 4; ++e) rl[4 * q + e] = __builtin_amdgcn_rcpf(l4[e]); }
          ATT_LAS unsigned short* stg = (ATT_LAS unsigned short*)(lds + LB_ST + wid * 2560);
          const size_t ro = (tok0 + P0 + wid * 32) * 2048 + (size_t)h * 64, roo = (tok0 + P0 + wid * 32) * OPITCH + (size_t)h * 64;
#pragma unroll
          for (int d0 = 0; d0 < 2; ++d0) {
#pragma unroll
              for (int r = 0; r < 16; ++r) stg[((r & 3) + 8 * (r >> 2) + 4 * hi) * 40 + r32] = (unsigned short)(cvtpk(o[d0][r] * rl[r], 0.f) & 0xffffu);
              asm volatile("s_waitcnt lgkmcnt(0)" ::: "memory");
#pragma unroll
              for (int j = 0; j < 2; ++j) { const int id = lane + 64 * j, row = id >> 2, cg = id & 3;
                  const u32x4 ov = *(ATT_LAS const u32x4*)(stg + row * 40 + cg * 8);
                  const size_t off = ro + (size_t)row * 2048 + d0 * 32 + cg * 8, offo = roo + (size_t)row * OPITCH + d0 * 32 + cg * 8;
                  const u32x4 zz = *(const u32x4*)(T.Z + off);
                  const unsigned ow[4] = {ov.x, ov.y, ov.z, ov.w}, zw[4] = {zz.x, zz.y, zz.z, zz.w}; unsigned res[4];
#pragma unroll
                  for (int e = 0; e < 4; ++e) { const float z0 = __uint_as_float(zw[e] << 16), z1 = __uint_as_float(zw[e] & 0xffff0000u), v0 = __uint_as_float(ow[e] << 16), v1 = __uint_as_float(ow[e] & 0xffff0000u);
                      res[e] = cvtpk(v0 * z0 * __builtin_amdgcn_rcpf(1.0f + __builtin_amdgcn_exp2f(-LOG2E * z0)), v1 * z1 * __builtin_amdgcn_rcpf(1.0f + __builtin_amdgcn_exp2f(-LOG2E * z1))); }
                  *(u32x4*)(T.O + offo) = (u32x4){res[0], res[1], res[2], res[3]}; }
              asm volatile("s_waitcnt lgkmcnt(0)" ::: "memory"); } }
        asm volatile("s_waitcnt lgkmcnt(0)" ::: "memory");
    }
    __syncthreads();
}
}
static_assert(att::LB_END <= LDSCTL_OFF, "attention LDS inside the ring region");

struct Args { const void* in[18]; float* out; unsigned char* ws; };
#ifndef PH_MASK
#define PH_MASK 0xffff
#endif
#define PH(k) ((PH_MASK >> (k)) & 1)
#ifndef DUP_MASK
#define DUP_MASK 0
#endif
#define REP(k) for (int rep_ = 0; rep_ < (((DUP_MASK >> (k)) & 1) ? 2 : 1); ++rep_)

__device__ __forceinline__ float wave_sum(float v) {
#pragma unroll
    for (int o = 1; o < 64; o <<= 1) v += __shfl_xor(v, o);
    return v;
}
__device__ __forceinline__ int ropeidx(int p) { const int j = p >> 3, e = p & 7; return e < 4 ? 4 * j + e : 32 + 4 * j + (e - 4); }

struct CvtJob { const float* W; const float* W2; const float* gain; bf16* WT; int K, N, N2, kind, op, ldo; };
template <bool NT = true>
__device__ __forceinline__ void cvt_load(const CvtJob& J, int item, int lane, int nblk, f32x4 (&r)[8]) {
    const int kb = item / nblk, nb = item - kb * nblk, k0 = 64 * kb + 8 * (lane & 7), n = 32 * nb + 4 * (lane >> 3);
    const float* src = J.W; int col = n, ld = J.N;
    if (J.kind == 6) {
        if (n < 1536) col = n; else if (n < 3584) col = 4160 + (n - 1536); else if (n < 3840) col = 6208 + (n - 3584); else if (n < 5888) col = 8768 + (n - 3840);
        else if (n < 7936) col = 10816 + (n - 5888); else if (n < 9984) col = 6720 + (n - 7936); else if (n < 12032) col = 2112 + (n - 9984); else if (n < 14080) col = 14928 + (n - 12032); else { src = J.W2; col = n - 14080; ld = J.N2; }
    } else if (J.kind == 7) {
        if (n < 512) col = 1536 + n; else if (n < 768) col = 6464 + (n - 512);
        else if (n < 2816) col = 12864 + (n - 768);
        else { const int lc = n - 2816; col = lc < 64 ? 2048 + ropeidx(lc) : (lc < 80 ? 14912 + (lc - 64) : -1); }
    } else if (J.kind == 1) { const int hh = n / 192, c = n - hh * 192; col = hh * 192 + (c < 128 ? c : 128 + ropeidx(c - 128)); }
    else if (J.kind == 2) { if (n >= 2048) { src = J.W2; col = n - 2048; } }
    const float* p = src + (size_t)k0 * ld + (col >= 0 ? col : 0);
#pragma unroll
    for (int i = 0; i < 8; ++i) { r[i] = (f32x4){0.f, 0.f, 0.f, 0.f}; if (col >= 0) { if constexpr (NT) r[i] = __builtin_nontemporal_load((const f32x4*)(p + (size_t)i * ld)); else r[i] = *(const f32x4*)(p + (size_t)i * ld); } }
}
__device__ __forceinline__ void cvt_store(const CvtJob& J, int item, int lane, int nblk, f32x4 (&r)[8]) {
    const int kb = item / nblk, nb = item - kb * nblk, k0 = 64 * kb + 8 * (lane & 7), n = 32 * nb + 4 * (lane >> 3);
    if (J.gain) { const f32x4 g0 = *(const f32x4*)(J.gain + k0), g1 = *(const f32x4*)(J.gain + k0 + 4);
        r[0] = r[0] * g0[0]; r[1] = r[1] * g0[1]; r[2] = r[2] * g0[2]; r[3] = r[3] * g0[3]; r[4] = r[4] * g1[0]; r[5] = r[5] * g1[1]; r[6] = r[6] * g1[2]; r[7] = r[7] * g1[3]; }
    const int ldo = J.ldo ? J.ldo : J.K;
    bf16* o = J.WT + (size_t)n * ldo + k0;
#pragma unroll
    for (int e = 0; e < 4; ++e) { v4u w; w.x = pk2(r[0][e], r[1][e]); w.y = pk2(r[2][e], r[3][e]); w.z = pk2(r[4][e], r[5][e]); w.w = pk2(r[6][e], r[7][e]);
        *(GAS v4u*)(o + (size_t)e * ldo) = w; }
}
typedef unsigned u32x4_t __attribute__((ext_vector_type(4)));
__device__ __forceinline__ int q8(float v, float inv) { return (int)rintf(v * inv) & 0xff; }
__device__ __forceinline__ void cvt_store8(const CvtJob& J, int item, int lane, int nblk, f32x4 (&r)[8]) {
    const int kb = item / nblk, nb = item - kb * nblk, k0 = 64 * kb + 8 * (lane & 7), n = 32 * nb + 4 * (lane >> 3);
    unsigned char* o = (unsigned char*)J.WT + (size_t)n * J.K + k0;
    const f32x4 cm = *(const f32x4*)(J.gain + n);
#pragma unroll
    for (int e = 0; e < 4; ++e) { const float inv = 127.0f / fmaxf(cm[e], 1e-30f);
        const unsigned w0 = (unsigned)q8(r[0][e], inv) | ((unsigned)q8(r[1][e], inv) << 8) | ((unsigned)q8(r[2][e], inv) << 16) | ((unsigned)q8(r[3][e], inv) << 24);
        const unsigned w1 = (unsigned)q8(r[4][e], inv) | ((unsigned)q8(r[5][e], inv) << 8) | ((unsigned)q8(r[6][e], inv) << 16) | ((unsigned)q8(r[7][e], inv) << 24);
        *(GAS unsigned long long*)(o + (size_t)e * J.K) = (unsigned long long)w0 | ((unsigned long long)w1 << 32); }
}
__device__ __forceinline__ void cvt_absmax(const CvtJob& J, int item, int lane, int nblk, const f32x4 (&r)[8]) {
    const int kb = item / nblk, nb = item - kb * nblk, n = 32 * nb + 4 * (lane >> 3); (void)kb;
    f32x4 mx = {0.f, 0.f, 0.f, 0.f};
#pragma unroll
    for (int i = 0; i < 8; ++i)
#pragma unroll
        for (int e = 0; e < 4; ++e) mx[e] = fmaxf(mx[e], fabsf(r[i][e]));
#pragma unroll
    for (int e = 0; e < 4; ++e) { mx[e] = fmaxf(mx[e], __shfl_xor(mx[e], 1)); mx[e] = fmaxf(mx[e], __shfl_xor(mx[e], 2)); mx[e] = fmaxf(mx[e], __shfl_xor(mx[e], 4)); }
    if ((lane & 7) == 0) {
#pragma unroll
        for (int e = 0; e < 4; ++e) atomicMax((unsigned*)J.WT + n + e, __float_as_uint(mx[e])); }
}
__device__ __forceinline__ void strip_pack(const f32x4 (&ra)[8], unsigned (&p)[16], f32x4& mx) {
#pragma unroll
    for (int r = 0; r < 8; ++r) {
#pragma unroll
        for (int e = 0; e < 4; ++e) mx[e] = fmaxf(mx[e], fabsf(ra[r][e]));
        p[2 * r] = pk2(ra[r][0], ra[r][1]); p[2 * r + 1] = pk2(ra[r][2], ra[r][3]); }
}
__device__ __forceinline__ void strip_quant(const unsigned (&pc)[16], const f32x4& inv, unsigned char* o, int K) {
#pragma unroll
    for (int e = 0; e < 4; ++e) { unsigned w[2] = {0u, 0u};
#pragma unroll
        for (int r = 0; r < 8; ++r) { const unsigned p = pc[2 * r + (e >> 1)]; const float v = (e & 1) ? __uint_as_float(p & 0xffff0000u) : __uint_as_float(p << 16);
            w[r >> 2] |= (unsigned)q8(v, inv[e]) << (8 * (r & 3)); }
        *(GAS unsigned long long*)(o + (size_t)e * K) = (unsigned long long)w[0] | ((unsigned long long)w[1] << 32); }
}
__device__ __forceinline__ void cvt_strip_i8(const CvtJob& J, int nb, int nblk, LAS unsigned* cmx, LAS unsigned char* hold, float* SB, int wave, int lane, int tid) {
    if (tid < 32) cmx[tid] = 0u;
    __syncthreads();
    const int n = 4 * (lane >> 3);
    LAS u32x4_t* hp = (LAS u32x4_t*)hold + tid;
    f32x4 mx = {0.f, 0.f, 0.f, 0.f};
    unsigned p0[16], p1[16], p2[16], p3[16];
    { f32x4 ra[8], rb[8]; cvt_load(J, (wave + 0) * nblk + nb, lane, nblk, ra); cvt_load(J, (wave + 8) * nblk + nb, lane, nblk, rb); strip_pack(ra, p0, mx); strip_pack(rb, p1, mx); }
    asm volatile("" ::: "memory");
    { f32x4 ra[8], rb[8]; cvt_load(J, (wave + 16) * nblk + nb, lane, nblk, ra); cvt_load(J, (wave + 24) * nblk + nb, lane, nblk, rb); strip_pack(ra, p2, mx); strip_pack(rb, p3, mx); }
    asm volatile("" ::: "memory");
#pragma unroll 1
    for (int i = 4; i < 8; i += 2) {
        f32x4 ra[8], rb[8]; cvt_load(J, (wave + 8 * i) * nblk + nb, lane, nblk, ra); cvt_load(J, (wave + 8 * i + 8) * nblk + nb, lane, nblk, rb);
        unsigned pa[16], pb[16]; strip_pack(ra, pa, mx); strip_pack(rb, pb, mx);
        LAS u32x4_t* hq = hp + (i - 4) * 4 * 512;
#pragma unroll
        for (int j = 0; j < 4; ++j) { hq[j * 512] = (u32x4_t){pa[4 * j], pa[4 * j + 1], pa[4 * j + 2], pa[4 * j + 3]}; hq[(4 + j) * 512] = (u32x4_t){pb[4 * j], pb[4 * j + 1], pb[4 * j + 2], pb[4 * j + 3]}; }
    }
#pragma unroll
    for (int e = 0; e < 4; ++e) { mx[e] = fmaxf(mx[e], __shfl_xor(mx[e], 1)); mx[e] = fmaxf(mx[e], __shfl_xor(mx[e], 2)); mx[e] = fmaxf(mx[e], __shfl_xor(mx[e], 4)); }
    if ((lane & 7) == 0) {
#pragma unroll
        for (int e = 0; e < 4; ++e) (void)__hip_atomic_fetch_max((unsigned*)(cmx + n + e), __float_as_uint(mx[e]), __ATOMIC_RELAXED, __HIP_MEMORY_SCOPE_WORKGROUP); }
    __syncthreads();
    f32x4 inv; { const u32x4_t c4 = *(LAS const u32x4_t*)(cmx + n);
#pragma unroll
        for (int e = 0; e < 4; ++e) inv[e] = 127.0f / fmaxf(__uint_as_float(c4[e]), 1e-30f); }
    if (tid < 32) SB[32 * nb + tid] = fmaxf(__uint_as_float(cmx[tid]), 1e-30f) * (1.0f / 127.0f);
    unsigned char* o = (unsigned char*)J.WT + (size_t)(32 * nb + n) * J.K + 64 * wave + 8 * (lane & 7);
    strip_quant(p0, inv, o, J.K); strip_quant(p1, inv, o + 512, J.K); strip_quant(p2, inv, o + 1024, J.K); strip_quant(p3, inv, o + 1536, J.K);
#pragma unroll 1
    for (int i = 4; i < 8; ++i) { unsigned pc[16]; LAS u32x4_t* hq = hp + (i - 4) * 4 * 512;
#pragma unroll
        for (int j = 0; j < 4; ++j) { const u32x4_t t4 = hq[j * 512]; pc[4 * j] = t4.x; pc[4 * j + 1] = t4.y; pc[4 * j + 2] = t4.z; pc[4 * j + 3] = t4.w; }
        strip_quant(pc, inv, o + 512 * i, J.K); }
    __syncthreads();
}
__device__ __forceinline__ void cvt_job(const CvtJob& J, int ndst, int gw, int ngw, int lane) {
    constexpr int NI = 4;
    const int nblk = ndst / 32, nitems = (J.K / 64) * nblk;
    for (int it = gw; it < nitems; it += NI * ngw) {
        f32x4 r[NI][8];
#pragma unroll
        for (int q = 0; q < NI; ++q) if (it + q * ngw < nitems) cvt_load(J, it + q * ngw, lane, nblk, r[q]);
#pragma unroll
        for (int q = 0; q < NI; ++q) if (it + q * ngw < nitems) {
            if (J.op == 4) cvt_store8(J, it + q * ngw, lane, nblk, r[q]);
            else if (J.op == 5) cvt_absmax(J, it + q * ngw, lane, nblk, r[q]);
            else cvt_store(J, it + q * ngw, lane, nblk, r[q]); }
    }
}

__device__ __forceinline__ float wave_max(float v) {
#pragma unroll
    for (int o = 1; o < 64; o <<= 1) v = fmaxf(v, __shfl_xor(v, o));
    return v;
}
__device__ __forceinline__ void rms_store_i8(f32x4 (&v)[16], const float* g, bf16* orow, unsigned char* orow8, float* sa, int lane) {
    float s = 0.f;
#pragma unroll
    for (int j = 0; j < 16; ++j) s += (v[j].x * v[j].x + v[j].y * v[j].y) + (v[j].z * v[j].z + v[j].w * v[j].w);
    const float rs = 1.0f / sqrtf(wave_sum(s) * (1.0f / DM) + 1e-6f);
    GAS unsigned* q8p = (GAS unsigned*)orow8 + lane; GAS unsigned long long* o8 = (GAS unsigned long long*)orow + lane;
    float mx = 0.f;
#pragma unroll
    for (int j = 0; j < 16; ++j) { const f32x4 gg = *((const GAS f32x4*)g + lane + 64 * j);
        v[j].x = v[j].x * rs * gg.x; v[j].y = v[j].y * rs * gg.y; v[j].z = v[j].z * rs * gg.z; v[j].w = v[j].w * rs * gg.w;
        mx = fmaxf(fmaxf(mx, fmaxf(fabsf(v[j].x), fabsf(v[j].y))), fmaxf(fabsf(v[j].z), fabsf(v[j].w)));
        o8[64 * j] = (unsigned long long)pk2(v[j].x, v[j].y) | ((unsigned long long)pk2(v[j].z, v[j].w) << 32); }
    mx = fmaxf(wave_max(mx), 1e-30f);
    const float inv = 127.0f / mx;
    if (lane == 0) sa[0] = mx * (1.0f / 127.0f);
#pragma unroll
    for (int j = 0; j < 16; ++j) q8p[64 * j] = (unsigned)q8(v[j].x, inv) | ((unsigned)q8(v[j].y, inv) << 8) | ((unsigned)q8(v[j].z, inv) << 16) | ((unsigned)q8(v[j].w, inv) << 24);
}

#define CONVERT_LAYER(LL) do { const int ll_ = (LL); unsigned char* wl = ws + WS_W + (size_t)ll_ * W_LAYER; \
        { constexpr int NSTRIP = N8 / 32; LAS unsigned* cmx = (LAS unsigned*)(lds + RING_OFF + RING_BYTES);   \
          for (int s = vcu; s < NSTRIP; s += G) { \
              CvtJob J{IN_F(4) + (size_t)ll_ * DM * NIN, IN_F(15) + (size_t)ll_ * DM * NMRG, nullptr, (bf16*)(wl + W_BIG), DM, NIN, NMRG, 6, 4}; \
              cvt_strip_i8(J, s, NSTRIP, cmx, lds + RING_OFF, (float*)(ws + WS_SB) + (size_t)ll_ * N8, wave, lane, tid); } } \
        { CvtJob J{IN_F(4) + (size_t)ll_ * DM * NIN, nullptr, nullptr, (bf16*)(wl + W_BIG16), DM, NIN, 0, 7, 0}; cvt_job(J, N16, gw, NGW, lane); } \
        { CvtJob J{IN_F(7) + (size_t)ll_ * 1536 * 3072, nullptr, IN_F(5) + ll_ * 1536, (bf16*)(wl + W_UQ), 1536, 3072, 0, 1, 0}; cvt_job(J, 3072, gw, NGW, lane); } \
        { CvtJob J{IN_F(8) + (size_t)ll_ * 512 * 2048, IN_F(9) + (size_t)ll_ * 512 * 2048, IN_F(6) + ll_ * 512, (bf16*)(wl + W_UKV), 512, 2048, 2048, 2, 0}; cvt_job(J, 4096, gw, NGW, lane); } \
          \
        { CvtJob J{IN_F(12) + (size_t)ll_ * 2048 * DM, nullptr, nullptr, (bf16*)(wl + W_PROJ), 2048, DM, 0, 3, 0, 6144}; cvt_job(J, DM, gw, NGW, lane); } \
        { CvtJob J{IN_F(13) + (size_t)ll_ * 2048 * DM, nullptr, nullptr, (bf16*)(wl + W_PROJ) + 2048, 2048, DM, 0, 3, 0, 6144}; cvt_job(J, DM, gw, NGW, lane); } \
        { CvtJob J{IN_F(14) + (size_t)ll_ * 2048 * DM, nullptr, nullptr, (bf16*)(wl + W_PROJ) + 4096, 2048, DM, 0, 3, 0, 6144}; cvt_job(J, DM, gw, NGW, lane); } \
        { CvtJob J{IN_F(16) + (size_t)ll_ * DM * DM, nullptr, nullptr, (bf16*)(wl + W_O), DM, DM, 0, 3, 0}; cvt_job(J, DM, gw, NGW, lane); } \
        __syncthreads(); } while (0)
#define KAS __attribute__((address_space(4)))
#define KARG(k) ({ const KAS char* kp_ = (const KAS char*)__builtin_amdgcn_kernarg_segment_ptr(); asm volatile("" : "+s"(kp_)); *(const void* const KAS*)(kp_ + 8 * (k)); })
#define IN_F(k) ((const float*)KARG(k))
#define WSP ((unsigned char*)KARG(19))
__global__ void __launch_bounds__(NWAVES * 64, 2) mk_fwd(Args args) {
    extern __shared__ __attribute__((aligned(16))) unsigned char lds_raw[];
    LAS unsigned char* lds = (LAS unsigned char*)lds_raw;
    volatile LAS unsigned* MISC = (volatile LAS unsigned*)(lds + MISC_OFF);
    const int G = gridDim.x, bx = blockIdx.x, vcu = (G % 8 == 0) ? (bx % 8) * (G / 8) + bx / 8 : bx;
    for (int u = threadIdx.x; u < (LDS_BYTES - LDSCTL_OFF) / 4; u += NWAVES * 64) ((LAS unsigned*)(lds + LDSCTL_OFF))[u] = 0u;
    __syncthreads();
    (void)xcd_barrier_post((unsigned*)((gu32*)(WSP + WS_CTL) + CW_BAR), MISC + 8);
#if defined(TEST_DOUBLE_BAR)
#define GRID_BAR() do { GRID_BAR1(); GRID_BAR1(); } while (0)
#else
#define GRID_BAR() GRID_BAR1()
#endif
#define GRID_BAR1() do { XcdBarrier b_; b_.bar = (unsigned*)((gu32*)(WSP + WS_CTL) + CW_BAR); b_.x = xb_xcc_id(); b_.st = MISC + 8; xcd_barrier(b_); } while (0)
    const int NGW = G * NWAVES;
#define PHASE_LOCALS() int tid_l = threadIdx.x; asm volatile("" : "+v"(tid_l)); const int tid = tid_l, lane = tid & 63, wave = __builtin_amdgcn_readfirstlane(tid >> 6), gw = vcu * NWAVES + wave; unsigned char* ws = WSP; (void)lane; (void)gw; (void)ws

    if (PH(0)) REP(0) {
        PHASE_LOCALS();
        CONVERT_LAYER(0);
        { float* ropeC = (float*)(ws + WS_ROPEC); float* ropeS = (float*)(ws + WS_ROPES); const int* positions = (const int*)KARG(1);
          for (int i = bx * 512 + tid; i < M * 32; i += G * 512) { const int m = i >> 5, k = i & 31;
            const float inv = exp2f(-(float)k * (13.287712379549449f / 32.0f));
            const float ang = (float)positions[m] * inv; float s, c; sincosf(ang, &s, &c); ropeC[i] = c; ropeS[i] = s; }
          unsigned long long* RS = (unsigned long long*)(ws + WS_RS);
          for (int i = bx * 512 + tid; i < 4 * M; i += G * 512) RS[i] = 0ull; }
        { const float* x_in = IN_F(0); const float* pre_norm = IN_F(3);
          for (int m = gw; m < M; m += NGW) { f32x4 v[16]; const GAS f32x4* xr = (const GAS f32x4*)(x_in + (size_t)m * DM) + lane;
#pragma unroll
            for (int j = 0; j < 16; ++j) v[j] = xr[64 * j];
            rms_store_i8(v, pre_norm, (bf16*)(ws + WS_H) + (size_t)m * DM, ws + WS_H8 + (size_t)m * DM, (float*)(ws + WS_SA) + m, lane); } }
    }
    GRID_BAR();

#ifndef TEST_NLAYERS
#define TEST_NLAYERS 2
#endif
    for (int l = 0; l < TEST_NLAYERS; ++l) {
        if (PH(2)) REP(2) {
            unsigned char* ws = WSP; unsigned char* wl = ws + WS_W + (size_t)l * W_LAYER;
            pg8::Gemm g{(const bf16*)(ws + WS_H), (const bf16*)(wl + W_BIG16), M, N16, DM}; pg8::StaticOrder S; S.init(M, N16, G, bx);
            pg8::EpiBig<false> E{ws, IN_F(11) + l * 16, l};
            pg8::gemm_phase<pg8::EpiBig<false>, pg8::StaticOrder, GALIGN, true, false>(lds + RING_OFF, g, S, E);
        }
        if (PH(1)) REP(1) {
            unsigned char* ws = WSP; unsigned char* wl = ws + WS_W + (size_t)l * W_LAYER;
            pg8::Gemm g{(const bf16*)(ws + WS_H8), (const bf16*)(wl + W_BIG), M, N8, DM / 2}; pg8::StaticOrder S; S.init(M, N8, G, bx);
            pg8::EpiBig<true> E{ws, IN_F(11) + l * 16, l};
            pg8::gemm_phase<pg8::EpiBig<true>, pg8::StaticOrder, GALIGN, true, true>(lds + RING_OFF, g, S, E);
        }
        GRID_BAR();
#if defined(TEST_HASHG)
        {
            PHASE_LOCALS();
#ifndef HASH_OFF
#define HASH_OFF WS_GATES
#define HASH_WORDS ((size_t)M * NMRG / 2)
#endif
            unsigned hg = 0u; const unsigned* gp = (const unsigned*)(ws + HASH_OFF);
            for (size_t i = (size_t)bx * 512 + tid; i < HASH_WORDS; i += (size_t)G * 512) hg += gp[i] * 2654435761u + (unsigned)i;
            atomicAdd((unsigned*)(ws + WS_CTL) + 2050, hg);
        }
#endif
        if (PH(3) && vcu < 128) REP(3) {
            PHASE_LOCALS();
            const int b = vcu >> 4, hh = vcu & 15; const float* lf = (const float*)(ws + WS_LOGF) + (size_t)b * SEQ * 16 + hh;
            float v0 = lf[(size_t)(4 * tid) * 16], v1 = lf[(size_t)(4 * tid + 1) * 16], v2 = lf[(size_t)(4 * tid + 2) * 16], v3 = lf[(size_t)(4 * tid + 3) * 16];
            v1 += v0; v2 += v1; v3 += v2;
            float inc = v3;
#pragma unroll
            for (int o = 1; o < 64; o <<= 1) { const float t = __shfl_up(inc, o); if (lane >= o) inc += t; }
            LAS float* wsum = (LAS float*)(lds + RING_OFF);
            if (lane == 63) wsum[wave] = inc;
            __syncthreads();
            float base = inc - v3;
            for (int w = 0; w < wave; ++w) base += wsum[w];
            float* cb = (float*)(ws + WS_CB) + ((size_t)b * 16 + hh) * SEQ + 4 * tid;
            *(f32x4*)cb = (f32x4){-(base + v0) * LOG2E_F, -(base + v1) * LOG2E_F, -(base + v2) * LOG2E_F, -(base + v3) * LOG2E_F};
            __syncthreads();
        }
        if (PH(3)) REP(3) {
            unsigned char* ws = WSP; unsigned char* wl = ws + WS_W + (size_t)l * W_LAYER;
            pg8::Gemm g{(const bf16*)(ws + WS_ACQ), (const bf16*)(wl + W_UQ), M, 3072, 1536}; pg8::StaticOrder S; S.init(M, 3072, G, bx);
            pg8::EpiQA E{ws, l};
            pg8::gemm_phase<pg8::EpiQA, pg8::StaticOrder, GALIGN, true>(lds + RING_OFF, g, S, E);
        }
        if (PH(4)) REP(4) {
            unsigned char* ws = WSP; unsigned char* wl = ws + WS_W + (size_t)l * W_LAYER;
            pg8::Gemm g{(const bf16*)(ws + WS_ACKV), (const bf16*)(wl + W_UKV), M, 4096, 512}; pg8::StaticOrder S; S.init(M, 4096, G, bx);
            pg8::EpiKV E{ws, l};
            pg8::gemm_phase<pg8::EpiKV, pg8::StaticOrder, GALIGN, true>(lds + RING_OFF, g, S, E);
        }
        GRID_BAR();
        const int cgrp = (l == 0) ? (vcu >> 1) % 3 : -1;
        if (cgrp == 0) { PHASE_LOCALS(); CONVERT_LAYER(1); }
        if (PH(5)) REP(5) { unsigned char* ws = WSP;
            att::Args TA{(const bf16*)(ws + WS_QA), (const bf16*)(ws + WS_KA), (const bf16*)(ws + WS_KR), (const bf16*)(ws + WS_VA), (const bf16*)(ws + WS_AZ), (bf16*)(ws + WS_OCAT), nullptr, nullptr, nullptr};
            for (int e = vcu * 4; e < 1024; e += ((e & 3) == 3) ? G * 4 - 3 : 1) { const int uu = e >> 1, bh = uu >> 2, pr = uu & 3;
                att::attn_unit<0>(TA, bh >> 4, bh & 15, (e & 1) ? pr : 7 - pr, lds + RING_OFF); }
        }
        if (cgrp == 1) { PHASE_LOCALS(); CONVERT_LAYER(1); }
        if (PH(6)) REP(6) { unsigned char* ws = WSP;
            att::Args TC{(const bf16*)(ws + WS_CQ), (const bf16*)(ws + WS_CK), nullptr, (const bf16*)(ws + WS_CV), (const bf16*)(ws + WS_CZ), (bf16*)(ws + WS_OCAT) + 4096, (const float*)(ws + WS_CB), nullptr, nullptr};
            for (int e = vcu * 4; e < 1024; e += ((e & 3) == 3) ? G * 4 - 3 : 1) { const int uu = e >> 1, bh = uu >> 2, pr = uu & 3;
                att::attn_unit<2>(TC, bh >> 4, bh & 15, (e & 1) ? pr : 7 - pr, lds + RING_OFF); }
        }
        if (PH(7)) REP(7) { unsigned char* ws = WSP;
            att::Args TB{(const bf16*)(ws + WS_BQ), (const bf16*)(ws + WS_BK), nullptr, (const bf16*)(ws + WS_BV), (const bf16*)(ws + WS_BZ), (bf16*)(ws + WS_OCAT) + 2048, nullptr, IN_F(2), IN_F(10) + l * 32};
            for (int u = vcu; u < 256; u += G) att::attn_unit_b(TB, u >> 5, (u >> 3) & 3, u & 7, lds + RING_OFF);
        }
        if (cgrp == 2) { PHASE_LOCALS(); CONVERT_LAYER(1); }
        GRID_BAR();
        if (PH(8)) REP(8) {
            unsigned char* ws = WSP; unsigned char* wl = ws + WS_W + (size_t)l * W_LAYER;
#if defined(P5_STAGGER)
            if (vcu & 1) { const unsigned long long t0_ = __builtin_amdgcn_s_memrealtime(); while (__builtin_amdgcn_s_memrealtime() - t0_ < (unsigned long long)(P5_STAGGER)) __builtin_amdgcn_s_sleep(32); }
#endif
            pg8::Gemm g{(const bf16*)(ws + WS_OCAT), (const bf16*)(wl + W_PROJ), M, DM, 6144}; pg8::StaticOrder S; S.init(M, DM, G, bx);
            pg8::EpiGate3 E{ws, WS_Y};
            pg8::gemm_phase<pg8::EpiGate3, pg8::StaticOrder, GALIGN, true>(lds + RING_OFF, g, S, E);
        }
        GRID_BAR();
        if (PH(9)) REP(9) {
            unsigned char* ws = WSP; unsigned char* wl = ws + WS_W + (size_t)l * W_LAYER;
            pg8::Gemm g{(const bf16*)(ws + WS_Y), (const bf16*)(wl + W_O), M, DM, DM, 1  }; pg8::StaticOrder S; S.init(M, DM, G, bx);
            pg8::EpiZ16 E{(bf16*)(ws + WS_Z), DM};
            pg8::gemm_phase<pg8::EpiZ16, pg8::StaticOrder, GALIGN, true>(lds + RING_OFF, g, S, E);
        }
        GRID_BAR();
        if (PH(10)) for (int rep_ = 0; rep_ < ((((DUP_MASK >> 10) & 1) && l == 0) ? 2 : 1); ++rep_) {
            PHASE_LOCALS();
            const float* pg = IN_F(17) + l * DM; float* xo = (float*)KARG(18); const float* x_res = l == 0 ? IN_F(0) : (const float*)xo; const float* pre1 = IN_F(3) + DM;
            for (int m = gw; m < M; m += NGW) { f32x4 v[16]; const GAS unsigned long long* zr = (const GAS unsigned long long*)(ws + WS_Z) + (size_t)(m >> 8) * 16 * 16384 + (m & 255) * 64 + lane;
                float s = 0.f;
#pragma unroll
                for (int j = 0; j < 16; ++j) { const unsigned long long zz = zr[16384 * j]; v[j].x = __uint_as_float((unsigned)zz << 16); v[j].y = __uint_as_float((unsigned)zz & 0xffff0000u); v[j].z = __uint_as_float((unsigned)(zz >> 32) << 16); v[j].w = __uint_as_float((unsigned)(zz >> 32) & 0xffff0000u);
                    s += (v[j].x * v[j].x + v[j].y * v[j].y) + (v[j].z * v[j].z + v[j].w * v[j].w); }
                const float rs = 1.0f / sqrtf(wave_sum(s) * (1.0f / DM) + 1e-6f);
                const GAS f32x4* xr = (const GAS f32x4*)(x_res + (size_t)m * DM) + lane; GAS f32x4* orow = (GAS f32x4*)(xo + (size_t)m * DM) + lane;
#pragma unroll
                for (int j = 0; j < 16; ++j) { const f32x4 gg = *((const GAS f32x4*)pg + lane + 64 * j); v[j] = xr[64 * j] + v[j] * rs * gg; orow[64 * j] = v[j]; }
                if (l == 0) rms_store_i8(v, pre1, (bf16*)(ws + WS_H) + (size_t)m * DM, ws + WS_H8 + (size_t)m * DM, (float*)(ws + WS_SA) + m, lane); }
        }
        if (l == 0) GRID_BAR();
    }
#if defined(TEST_MICRO)
    {
        PHASE_LOCALS();
        typedef int v8i_t __attribute__((ext_vector_type(8)));
        const unsigned char* A8 = ws + WS_W + W_LAYER + W_MRG8; const unsigned char* B8 = ws + WS_W + W_MRG8;
        const int r = lane & 15, kb = lane >> 4; unsigned hm = 0u;
        for (int tile = gw; tile < 512 * 16; tile += NGW) {
            const int ta = tile & 511, tb = tile >> 9;
            f32x4 accm = {0.f, 0.f, 0.f, 0.f};
            for (int kk = 0; kk < 32; ++kk) {
                const v8i_t av = *(const v8i_t*)(A8 + (size_t)(ta * 16 + r) * DM + kk * 128 + kb * 32);
                const v8i_t bv = *(const v8i_t*)(B8 + (size_t)(tb * 16 + r) * DM + kk * 128 + kb * 32);
#if TEST_MICRO == 1
                accm = __builtin_amdgcn_mfma_scale_f32_16x16x128_f8f6f4(bv, av, accm, 0, 0, 0, 0x7f7f7f7f, 0, 0x7f7f7f7f);
#else
                { const long a0 = ((long)(unsigned)av[0]) | ((long)av[1] << 32), b0 = ((long)(unsigned)bv[0]) | ((long)bv[1] << 32); accm = __builtin_amdgcn_mfma_f32_16x16x32_fp8_fp8(b0, a0, accm, 0, 0, 0); }
#endif
            }
            hm += (__float_as_uint(accm[0]) * 2654435761u) ^ (__float_as_uint(accm[1]) * 40503u) ^ (__float_as_uint(accm[2]) + __float_as_uint(accm[3]) * 7u);
        }
        atomicAdd((unsigned*)(ws + WS_CTL) + 2051, hm);
    }
#endif
#if defined(TEST_HASH)
    GRID_BAR();
    if (bx == 0 && threadIdx.x == 0) { unsigned char* ws = WSP; float* out = (float*)KARG(18);
        const unsigned a = __hip_atomic_load((unsigned*)(ws + WS_CTL) + 2048, __ATOMIC_RELAXED, __HIP_MEMORY_SCOPE_AGENT), b = __hip_atomic_load((unsigned*)(ws + WS_CTL) + 2049, __ATOMIC_RELAXED, __HIP_MEMORY_SCOPE_AGENT);
        const unsigned c = __hip_atomic_load((unsigned*)(ws + WS_CTL) + 2050, __ATOMIC_RELAXED, __HIP_MEMORY_SCOPE_AGENT); out[4] = (float)(c & 0xffffu) * 64.f; out[5] = (float)(c >> 16) * 64.f;
        { const unsigned d = __hip_atomic_load((unsigned*)(ws + WS_CTL) + 2051, __ATOMIC_RELAXED, __HIP_MEMORY_SCOPE_AGENT); out[6] = (float)(d & 0xffffu) * 64.f; out[7] = (float)(d >> 16) * 64.f; }
        out[0] = (float)(a & 0xffffu) * 64.f; out[1] = (float)(a >> 16) * 64.f; out[2] = (float)(b & 0xffffu) * 64.f; out[3] = (float)(b >> 16) * 64.f; }
#endif
#if defined(PROBE_P5)
    {
        GRID_BAR();
        unsigned char* ws = WSP; unsigned char* wl = ws + WS_W;
        pg8::Gemm g{(const bf16*)(ws + WS_OCAT), (const bf16*)(wl + W_PROJ), 3 * M, 3 * DM, 2048}; pg8::GateOrder S; S.S.init(M, DM, G, bx);
#if PROBE_P5 == 5
        pg8::EpiNull E{(float*)(ws + WS_CTL + 4096)};
        pg8::gemm_phase<pg8::EpiNull, pg8::GateOrder, true, true>(lds + RING_OFF, g, S, E);
#else
        pg8::EpiGateT<(PROBE_P5 - 1) & 3> E{ws, WS_QA};
        pg8::gemm_phase<pg8::EpiGateT<(PROBE_P5 - 1) & 3>, pg8::GateOrder, true, true>(lds + RING_OFF, g, S, E);
#endif
    }
#endif
#if defined(PROBE_ATTN)
    {
        GRID_BAR();
        unsigned char* ws = WSP;
        att::Args TC{(const bf16*)(ws + WS_CQ + 0), (const bf16*)(ws + WS_CV), nullptr, (const bf16*)(ws + WS_CV), (const bf16*)(ws + WS_CZ), (bf16*)(ws + WS_QA), (const float*)(ws + WS_CB), nullptr, nullptr};
        for (int rep = 0; rep < 2; ++rep)
        for (int e = vcu * 4; e < 1024; e += ((e & 3) == 3) ? G * 4 - 3 : 1) { const int uu = e >> 1, bh = uu >> 2, pr = uu & 3;
            att::attn_unit<2, PROBE_ATTN - 1>(TC, bh >> 4, bh & 15, (e & 1) ? pr : 7 - pr, lds + RING_OFF); }
    }
#endif
#if defined(PROBE_GEMM)
    {
        GRID_BAR();
        unsigned char* ws = WSP; unsigned char* wl = ws + WS_W;
        pg8::Gemm g{(const bf16*)(ws + WS_H), (const bf16*)(wl + W_BIG), M, NBIG, DM};
#if PROBE_GEMM == 1
        pg8::FixedOrder S{29, 0, 0, 0, 0};
#elif PROBE_GEMM == 2
        pg8::FixedOrder S{29, (int)(blockIdx.x & 63), (int)(blockIdx.x >> 6) * 29, 0, 1};
#else
        pg8::StaticOrder S; S.init(M, NBIG, G, bx);
#endif
#if PROBE_GEMM == 4
        pg8::EpiBig E{ws, IN_F(11), 2};
        pg8::gemm_phase<pg8::EpiBig, decltype(S), true, true>(lds + RING_OFF, g, S, E);
#else
        pg8::EpiNull E{(float*)(ws + WS_CTL + 4096)};
        pg8::gemm_phase<pg8::EpiNull, decltype(S), true, true>(lds + RING_OFF, g, S, E);
#endif
    }
#endif
}

extern "C" void kernel_launch(void* const* d_in, const int* in_sizes, int n_in, void* d_out, int out_size, void* d_ws, size_t ws_size, hipStream_t stream) {
    static int grid = 0;
    if (grid == 0) {
        if (n_in != 18 || out_size != M * DM || ws_size < WS_END) { fprintf(stderr, "kernel_launch: unexpected shapes (n_in %d out %d ws %zu)\n", n_in, out_size, ws_size); grid = -1; return; }
        int dev = 0, cus = 0, per_cu = 0;
        if (hipGetDevice(&dev) != hipSuccess || hipDeviceGetAttribute(&cus, hipDeviceAttributeMultiprocessorCount, dev) != hipSuccess) { grid = -1; return; }
        if (hipFuncSetAttribute((const void*)mk_fwd, hipFuncAttributeMaxDynamicSharedMemorySize, LDS_BYTES) != hipSuccess) { fprintf(stderr, "kernel_launch: hipFuncSetAttribute failed\n"); grid = -1; return; }
        if (hipOccupancyMaxActiveBlocksPerMultiprocessor(&per_cu, (const void*)mk_fwd, NWAVES * 64, LDS_BYTES) != hipSuccess || per_cu < 1)
            fprintf(stderr, "kernel_launch: note: occupancy query reports %d workgroups per CU\n", per_cu);
        (void)hipGetLastError();
        grid = cus;
    }
    if (grid < 0) return;
    if (hipMemsetAsync((char*)d_ws + WS_CTL, 0, CTL_ZERO_BYTES, stream) != hipSuccess) return;
    Args a{};
    for (int i = 0; i < 18; ++i) a.in[i] = d_in[i];
    a.out = (float*)d_out; a.ws = (unsigned char*)d_ws;
    hipLaunchKernelGGL(mk_fwd, dim3(grid), dim3(NWAVES * 64), LDS_BYTES, stream, a);
}
```
